# Optimizing an MI355X kernel written in HIP

```python
import jax, jax.numpy as jnp
from jax import lax
import numpy as np

D_MODEL = 1024
BATCH = 2
SEQ = 8192
DEPTH = 4

GRID_W = 64
CTX_LEN = 256
N_MIXERS = 2
EPS = 1e-6
NEG_INF = -1e30

GLA_HEADS = 4
GLA_DK = D_MODEL // 2
GLA_DV = D_MODEL
GLA_HK = GLA_DK // GLA_HEADS
GLA_HV = GLA_DV // GLA_HEADS
GLA_GATE_RANK = 16
GLA_GATE_NORM = 16.0
GLA_CHUNK = 64
GLA_IN = 2 * GLA_DK + 2 * GLA_DV + 2 * GLA_GATE_RANK

SWA_HEADS = 16
SWA_KV_HEADS = 2
SWA_HD = 64
SWA_WINDOW = 128
SWA_BLOCK = 128
SWA_Q = SWA_HEADS * SWA_HD
SWA_KV = SWA_KV_HEADS * SWA_HD
SWA_QKV = SWA_Q + 2 * SWA_KV
ROPE_THETA = 10000.0

FFN_HIDDEN = ((8 * D_MODEL + 3 * 256 - 1) // (3 * 256)) * 256

kernel_name = "hybrid_gla_swa_sink_prefix_dit"

f32 = jnp.float32


def rmsnorm(x, w):
    xf = x.astype(f32)
    y = xf * lax.rsqrt(jnp.mean(xf * xf, axis=-1, keepdims=True) + EPS)
    return (y * w.astype(f32)).astype(x.dtype)


def swiglu(h, w_in, w_out):
    g, u = jnp.split(h @ w_in, 2, axis=-1)
    return (jax.nn.silu(g) * u) @ w_out


def axial_rope(rows, head_dim):
    row = jnp.broadcast_to(jnp.arange(rows)[:, None], (rows, GRID_W)).reshape(-1).astype(f32)
    col = jnp.broadcast_to(jnp.arange(GRID_W)[None, :], (rows, GRID_W)).reshape(-1).astype(f32)
    n_freq = head_dim // 4
    inv = ROPE_THETA ** (-jnp.arange(n_freq, dtype=f32) / n_freq)
    ang = jnp.concatenate([row[:, None] * inv, col[:, None] * inv], axis=-1)
    return jnp.cos(ang), jnp.sin(ang)


def apply_rope(x, cos, sin):
    half = x.shape[-1] // 2
    x1, x2 = x[..., :half], x[..., half:]
    return jnp.concatenate([x1 * cos - x2 * sin, x2 * cos + x1 * sin], axis=-1).astype(x.dtype)


def gla_chunk_scan(q, k, v, g, s0):
    B, H, T, _ = q.shape
    HV = v.shape[-1]
    n = T // GLA_CHUNK

    def to_chunks(a):
        return a.reshape(B, H, n, GLA_CHUNK, a.shape[-1])

    q, k, v, g = to_chunks(q), to_chunks(k), to_chunks(v), to_chunks(g)
    b = jnp.cumsum(g, axis=3)
    b_last = b[:, :, :, -1:, :]
    q_dec = q * jnp.exp(b)
    k_inv = k * jnp.exp(-b)
    k_end = k * jnp.exp(b_last - b)
    tri = jnp.tril(jnp.ones((GLA_CHUNK, GLA_CHUNK), dtype=bool))
    a = jnp.where(tri, jnp.einsum('bhnid,bhnjd->bhnij', q_dec, k_inv), 0.0)
    o_intra = jnp.einsum('bhnij,bhnjv->bhniv', a, v)

    def step(s, inp):
        q_n, k_n, v_n, dec_n = inp
        o_n = jnp.einsum('bhid,bhdv->bhiv', q_n, s)
        s = s * dec_n[..., None] + jnp.einsum('bhjd,bhjv->bhdv', k_n, v_n)
        return s, o_n

    xs = (jnp.moveaxis(q_dec, 2, 0), jnp.moveaxis(k_end, 2, 0), jnp.moveaxis(v, 2, 0),
          jnp.moveaxis(jnp.exp(b_last[:, :, :, 0, :]), 2, 0))
    s_fin, o_inter = lax.scan(step, s0, xs)
    o = o_intra + jnp.moveaxis(o_inter, 0, 2)
    return o.reshape(B, H, T, HV), s_fin


def gla_mixer(hx, hc, w_in, w_gate_up, b_gate_up, w_o, o_norm, need_ctx):
    B = hx.shape[0]
    idx = [GLA_DK, 2 * GLA_DK, 2 * GLA_DK + GLA_DV, 2 * GLA_DK + 2 * GLA_DV,
           2 * GLA_DK + 2 * GLA_DV + GLA_GATE_RANK]

    def heads(a, hd):
        T = a.shape[1]
        return a.reshape(B, T, GLA_HEADS, hd).transpose(0, 2, 1, 3).astype(f32)

    def project(h):
        q, k, v, r, gf, gb = jnp.split(h @ w_in, idx, axis=-1)
        lg_f = jax.nn.log_sigmoid((gf @ w_gate_up[0] + b_gate_up[0]).astype(f32)) / GLA_GATE_NORM
        lg_b = jax.nn.log_sigmoid((gb @ w_gate_up[1] + b_gate_up[1]).astype(f32)) / GLA_GATE_NORM
        return (heads(q, GLA_HK) * (GLA_HK ** -0.5), heads(k, GLA_HK), heads(v, GLA_HV),
                heads(lg_f, GLA_HK), heads(lg_b, GLA_HK), r)

    qx, kx, vx, gxf, gxb, rx = project(hx)
    qc, kc, vc, gcf, gcb, rc = project(hc)
    s0 = jnp.zeros((B, GLA_HEADS, GLA_HK, GLA_HV), f32)

    def flip(a):
        return jnp.flip(a, axis=2)

    ocf, s_cf = gla_chunk_scan(qc, kc, vc, gcf, s0)
    ocb_rev, s_cb = gla_chunk_scan(flip(qc), flip(kc), flip(vc), flip(gcb), s0)
    oxf, _ = gla_chunk_scan(qx, kx, vx, gxf, s_cf)
    oxb_rev, _ = gla_chunk_scan(flip(qx), flip(kx), flip(vx), flip(gxb), s_cb)

    def finish(o, r):
        o = rmsnorm(o, o_norm)
        T = o.shape[2]
        o = o.transpose(0, 2, 1, 3).reshape(B, T, GLA_DV).astype(r.dtype) * jax.nn.silu(r)
        return o @ w_o

    out_x = finish(oxf + flip(oxb_rev), rx)
    out_c = finish(ocf + flip(ocb_rev), rc) if need_ctx else None
    return out_x, out_c


def swa_mixer(hx, hc, w_qkv, b_qkv, w_o, sinks, cos, sin, need_ctx):
    B, S, _ = hx.shape
    G = SWA_HEADS // SWA_KV_HEADS
    nb = S // SWA_BLOCK
    scale = SWA_HD ** -0.5

    def project(h):
        T = h.shape[1]
        q, k, v = jnp.split(h @ w_qkv + b_qkv, [SWA_Q, SWA_Q + SWA_KV], axis=-1)
        return (q.reshape(B, T, SWA_KV_HEADS, G, SWA_HD), k.reshape(B, T, SWA_KV_HEADS, SWA_HD),
                v.reshape(B, T, SWA_KV_HEADS, SWA_HD))

    qx, kx, vx = project(hx)
    qc, kc, vc = project(hc)
    qx = apply_rope(qx, cos[:, None, None, :], sin[:, None, None, :])
    kx = apply_rope(kx, cos[:, None, :], sin[:, None, :])

    qb = qx.reshape(B, nb, SWA_BLOCK, SWA_KV_HEADS, G, SWA_HD)

    def band(a):
        ap = jnp.pad(a, ((0, 0), (SWA_BLOCK, SWA_BLOCK), (0, 0), (0, 0)))
        ap = ap.reshape(B, nb + 2, SWA_BLOCK, SWA_KV_HEADS, SWA_HD)
        return jnp.concatenate([ap[:, :-2], ap[:, 1:-1], ap[:, 2:]], axis=2)

    kb, vb = band(kx), band(vx)
    qi = jnp.arange(nb)[:, None, None] * SWA_BLOCK + jnp.arange(SWA_BLOCK)[None, :, None]
    kj = jnp.arange(nb)[:, None, None] * SWA_BLOCK - SWA_BLOCK + jnp.arange(3 * SWA_BLOCK)[None, None, :]
    mask = (jnp.abs(kj - qi) <= SWA_WINDOW) & (kj >= 0) & (kj < S)

    s_win = jnp.einsum('bnqhgd,bnkhd->bhgnqk', qb, kb, preferred_element_type=f32) * scale
    s_win = jnp.where(mask, s_win, NEG_INF)
    s_ctx = jnp.einsum('bnqhgd,bkhd->bhgnqk', qb, kc, preferred_element_type=f32) * scale
    sink = sinks.astype(f32).reshape(SWA_KV_HEADS, G)[None, :, :, None, None, None]
    m = jnp.maximum(jnp.maximum(s_win.max(-1, keepdims=True), s_ctx.max(-1, keepdims=True)), sink)
    p_win = jnp.exp(s_win - m)
    p_ctx = jnp.exp(s_ctx - m)
    den = p_win.sum(-1, keepdims=True) + p_ctx.sum(-1, keepdims=True) + jnp.exp(sink - m)
    o = (jnp.einsum('bhgnqk,bnkhd->bnqhgd', p_win, vb.astype(f32))
         + jnp.einsum('bhgnqk,bkhd->bnqhgd', p_ctx, vc.astype(f32)))
    o = o / jnp.transpose(den, (0, 3, 4, 1, 2, 5))
    out_x = o.reshape(B, S, SWA_Q).astype(hx.dtype) @ w_o

    out_c = None
    if need_ctx:
        L = hc.shape[1]
        s_c = jnp.einsum('blhgd,bkhd->bhglk', qc, kc, preferred_element_type=f32) * scale
        sink_c = sinks.astype(f32).reshape(SWA_KV_HEADS, G)[None, :, :, None, None]
        m_c = jnp.maximum(s_c.max(-1, keepdims=True), sink_c)
        p_c = jnp.exp(s_c - m_c)
        den_c = p_c.sum(-1, keepdims=True) + jnp.exp(sink_c - m_c)
        o_c = jnp.einsum('bhglk,bkhd->blhgd', p_c, vc.astype(f32)) / jnp.transpose(den_c, (0, 3, 1, 2, 4))
        out_c = o_c.reshape(B, L, SWA_Q).astype(hc.dtype) @ w_o
    return out_x, out_c


def setup_inputs(seed: int = 0) -> dict:
    key = jax.random.key(seed)
    ks = jax.random.split(key, 20)
    n_gla = (DEPTH + 1) // 2
    n_swa = DEPTH // 2
    D = D_MODEL

    def nrm(k, shape, s):
        return jax.random.normal(k, shape, f32) * s

    return {
        "x": nrm(ks[0], (BATCH, SEQ, D), 1.0),
        "c": nrm(ks[1], (BATCH, D), 1.0),
        "ctx": nrm(ks[2], (BATCH, CTX_LEN, D), 1.0),
        "c_ctx": nrm(ks[3], (D,), 1.0),
        "w_ada": nrm(ks[4], (DEPTH, D, 6 * D), 0.5 * D ** -0.5),
        "b_ada": nrm(ks[5], (DEPTH, 6 * D), 0.01),
        "norm_mix": 1.0 + nrm(ks[6], (DEPTH, D), 0.02),
        "norm_ffn": 1.0 + nrm(ks[7], (DEPTH, D), 0.02),
        "gla_w_in": nrm(ks[8], (n_gla, D, GLA_IN), D ** -0.5),
        "gla_w_gate_up": nrm(ks[9], (n_gla, 2, GLA_GATE_RANK, GLA_DK), GLA_GATE_RANK ** -0.5),
        "gla_b_gate_up": nrm(ks[10], (n_gla, 2, GLA_DK), 0.1),
        "gla_w_o": nrm(ks[11], (n_gla, GLA_DV, D), GLA_DV ** -0.5),
        "gla_o_norm": 1.0 + nrm(ks[12], (n_gla, GLA_HV), 0.02),
        "swa_w_qkv": nrm(ks[13], (n_swa, D, SWA_QKV), D ** -0.5),
        "swa_b_qkv": nrm(ks[14], (n_swa, SWA_QKV), 0.01),
        "swa_w_o": nrm(ks[15], (n_swa, SWA_Q, D), SWA_Q ** -0.5),
        "swa_sinks": nrm(ks[16], (n_swa, SWA_HEADS), 0.5),
        "ffn_w_in": nrm(ks[17], (DEPTH, D, 2 * FFN_HIDDEN), D ** -0.5),
        "ffn_w_out": nrm(ks[18], (DEPTH, FFN_HIDDEN, D), FFN_HIDDEN ** -0.5),
        "norm_final": 1.0 + nrm(ks[19], (D,), 0.02),
    }


def reference(x, c, ctx, c_ctx, w_ada, b_ada, norm_mix, norm_ffn, gla_w_in, gla_w_gate_up,
              gla_b_gate_up, gla_w_o, gla_o_norm, swa_w_qkv, swa_b_qkv, swa_w_o, swa_sinks,
              ffn_w_in, ffn_w_out, norm_final):
    S = x.shape[1]
    rows = S // GRID_W
    cos, sin = axial_rope(rows, SWA_HD)

    mod_x = jnp.einsum('bd,lde->lbe', jax.nn.silu(c), w_ada) + b_ada[:, None, :]
    mod_c = jnp.einsum('d,lde->le', jax.nn.silu(c_ctx), w_ada) + b_ada

    for i in range(DEPTH):
        last = i == DEPTH - 1
        sh1, sc1, g1, sh2, sc2, g2 = jnp.split(mod_x[i][:, None, :], 6, axis=-1)
        csh1, csc1, cg1, csh2, csc2, cg2 = jnp.split(mod_c[i][None, None, :], 6, axis=-1)

        hx = rmsnorm(x, norm_mix[i]) * (1.0 + sc1) + sh1
        hc = rmsnorm(ctx, norm_mix[i]) * (1.0 + csc1) + csh1
        j = i // N_MIXERS
        if i % N_MIXERS == 0:
            ox, oc = gla_mixer(hx, hc, gla_w_in[j], gla_w_gate_up[j], gla_b_gate_up[j],
                               gla_w_o[j], gla_o_norm[j], not last)
        else:
            ox, oc = swa_mixer(hx, hc, swa_w_qkv[j], swa_b_qkv[j], swa_w_o[j], swa_sinks[j],
                               cos, sin, not last)
        x = x + g1 * ox
        x = x + g2 * swiglu(rmsnorm(x, norm_ffn[i]) * (1.0 + sc2) + sh2, ffn_w_in[i], ffn_w_out[i])
        if not last:
            ctx = ctx + cg1 * oc
            ctx = ctx + cg2 * swiglu(rmsnorm(ctx, norm_ffn[i]) * (1.0 + csc2) + csh2,
                                     ffn_w_in[i], ffn_w_out[i])

    return rmsnorm(x, norm_final)
```

```cpp
#include <hip/hip_runtime.h>
#include <cstdio>
#include <cstdint>

constexpr int D = 1024, BATCH = 2, SEQ = 8192, DEPTH = 4, CTXL = 256, GRID_W = 64;
constexpr int MX = BATCH * SEQ, MC = BATCH * CTXL, MT = MX + MC;
constexpr float EPS = 1e-6f;
constexpr int GH = 4, GDK = 512, GDV = 1024, GHK = 128, GHV = 256, GRANK = 16, GIN = 2 * GDK + 2 * GDV + 2 * GRANK;
constexpr int SH = 16, SKV = 2, SHD = 64, SQ = 1024, SKVD = 128, SQKV = 1280, SWIN = 128;
constexpr int FH = 2816;

__device__ __forceinline__ int rowvec(int r) { return r < MX ? r / SEQ : 2; }
__device__ __forceinline__ float siluf(float x) { return x / (1.f + __expf(-x)); }

__global__ void k_mod(const float* c, const float* c_ctx, const float* w_ada, const float* b_ada, float* mod) {
    const int e = blockIdx.x * 256 + threadIdx.x, l = blockIdx.y;
    __shared__ float s[3][D];
    for (int i = threadIdx.x; i < D; i += 256) { s[0][i] = siluf(c[i]); s[1][i] = siluf(c[D + i]); s[2][i] = siluf(c_ctx[i]); }
    __syncthreads();
    const float* w = w_ada + (size_t)l * D * 6 * D + e;
    float a0 = 0.f, a1 = 0.f, a2 = 0.f;
    for (int d = 0; d < D; ++d) { const float wv = w[(size_t)d * 6 * D]; a0 += s[0][d] * wv; a1 += s[1][d] * wv; a2 += s[2][d] * wv; }
    const float bb = b_ada[l * 6 * D + e];
    mod[((size_t)l * 3 + 0) * 6 * D + e] = a0 + bb; mod[((size_t)l * 3 + 1) * 6 * D + e] = a1 + bb; mod[((size_t)l * 3 + 2) * 6 * D + e] = a2 + bb;
}

__device__ __forceinline__ float block_sum256(float v, float* red) {
    for (int o = 32; o > 0; o >>= 1) v += __shfl_xor(v, o);
    __syncthreads();
    if ((threadIdx.x & 63) == 0) red[threadIdx.x >> 6] = v;
    __syncthreads();
    return red[0] + red[1] + red[2] + red[3];
}

__global__ void k_norm_mod(const float* X, const float* w, const float* modl, int sh_off, float* H) {
    __shared__ float red[4];
    const int r = blockIdx.x; const float* x = X + (size_t)r * D;
    float v[4]; float ss = 0.f;
    for (int j = 0; j < 4; ++j) { v[j] = x[threadIdx.x + 256 * j]; ss += v[j] * v[j]; }
    ss = block_sum256(ss, red);
    const float rs = rsqrtf(ss * (1.f / D) + EPS);
    for (int j = 0; j < 4; ++j) { const int cidx = threadIdx.x + 256 * j; float y = v[j] * rs * w[cidx];
        if (modl) { const float* m = modl + (size_t)rowvec(r) * 6 * D; y = y * (1.f + m[sh_off + D + cidx]) + m[sh_off + cidx]; }
        H[(size_t)r * D + cidx] = y; }
}

template <int MODE>
__global__ void __launch_bounds__(256) k_gemm(const float* A, int lda, const float* B, int ldb, float* C, int ldc, int N, int K, const float* bias, const float* gate) {
    __shared__ float As[16][132], Bs[16][132], Bu[MODE == 2 ? 16 : 1][132];
    const int tx = threadIdx.x & 15, ty = threadIdx.x >> 4;
    const int r0 = blockIdx.y * 128, c0 = blockIdx.x * 128;
    float acc[8][8], accu[MODE == 2 ? 8 : 1][8];
    for (int i = 0; i < 8; ++i) for (int j = 0; j < 8; ++j) acc[i][j] = 0.f;
    if (MODE == 2) for (int i = 0; i < 8; ++i) for (int j = 0; j < 8; ++j) accu[i][j] = 0.f;
    for (int k0 = 0; k0 < K; k0 += 16) {
        for (int i = threadIdx.x; i < 128 * 16; i += 256) { const int rr = i >> 4, kk = i & 15; As[kk][rr] = A[(size_t)(r0 + rr) * lda + k0 + kk]; }
        for (int i = threadIdx.x; i < 128 * 16; i += 256) { const int kk = i >> 7, cc = i & 127; const int col = c0 + cc;
            Bs[kk][cc] = col < N ? B[(size_t)(k0 + kk) * ldb + col] : 0.f;
            if (MODE == 2) Bu[kk][cc] = col < N ? B[(size_t)(k0 + kk) * ldb + col + N] : 0.f; }
        __syncthreads();
        for (int kk = 0; kk < 16; ++kk) {
            float a[8], b[8];
            for (int i = 0; i < 8; ++i) a[i] = As[kk][ty * 8 + i];
            for (int j = 0; j < 8; ++j) b[j] = Bs[kk][tx * 8 + j];
            for (int i = 0; i < 8; ++i) for (int j = 0; j < 8; ++j) acc[i][j] += a[i] * b[j];
            if (MODE == 2) { for (int j = 0; j < 8; ++j) b[j] = Bu[kk][tx * 8 + j];
                for (int i = 0; i < 8; ++i) for (int j = 0; j < 8; ++j) accu[i][j] += a[i] * b[j]; }
        }
        __syncthreads();
    }
    for (int i = 0; i < 8; ++i) { const int r = r0 + ty * 8 + i;
        for (int j = 0; j < 8; ++j) { const int col = c0 + tx * 8 + j; if (col >= N) continue;
            float* p = C + (size_t)r * ldc + col;
            if (MODE == 0) *p = acc[i][j] + (bias ? bias[col] : 0.f);
            else if (MODE == 1) *p += gate[(size_t)rowvec(r) * 6 * D + col] * acc[i][j];
            else *p = siluf(acc[i][j]) * accu[i][j]; } }
}

__device__ __forceinline__ float logsigf(float x) { return fminf(x, 0.f) - log1pf(__expf(-fabsf(x))); }
__global__ void __launch_bounds__(256) k_gla_scan(const float* Z, const float* wg  , const float* bg  , float* O) {
    const int vs = blockIdx.x & 15, h = (blockIdx.x >> 4) & 3, b = blockIdx.x >> 6;
    const int t = threadIdx.x, dv = t & 15, kg = t >> 4;
    __shared__ float sq[128], sk[128], sg[128], sv[16], sgf[16], swg[16][128], sbg[128], part[4][16];
    for (int dir = 0; dir < 2; ++dir) {
        for (int i = t; i < 16 * 128; i += 256) swg[i >> 7][i & 127] = wg[((size_t)dir * 16 + (i >> 7)) * 512 + h * 128 + (i & 127)];
        if (t < 128) sbg[t] = bg[dir * 512 + h * 128 + t];
        float S[8]; for (int i = 0; i < 8; ++i) S[i] = 0.f;
        __syncthreads();
        for (int step = 0; step < CTXL + SEQ; ++step) {
            int row;
            if (step < CTXL) row = MX + b * CTXL + (dir == 0 ? step : CTXL - 1 - step);
            else { const int s2 = step - CTXL; row = b * SEQ + (dir == 0 ? s2 : SEQ - 1 - s2); }
            const float* z = Z + (size_t)row * GIN;
            if (t < 128) { sq[t] = z[h * 128 + t] * 0.08838834764831845f; sk[t] = z[512 + h * 128 + t]; }
            if (t >= 128 && t < 144) sv[t - 128] = z[1024 + h * 256 + vs * 16 + (t - 128)];
            if (t >= 192 && t < 208) sgf[t - 192] = z[3072 + dir * 16 + (t - 192)];
            __syncthreads();
            if (t < 128) { float a = sbg[t]; for (int j = 0; j < 16; ++j) a += sgf[j] * swg[j][t]; sg[t] = __expf(logsigf(a) * (1.f / 16.f)); }
            __syncthreads();
            float o = 0.f; const float vv = sv[dv];
            for (int i = 0; i < 8; ++i) { const int dk = kg * 8 + i; S[i] = S[i] * sg[dk] + sk[dk] * vv; o += sq[dk] * S[i]; }
            o += __shfl_xor(o, 16); o += __shfl_xor(o, 32);
            if ((t & 63) < 16) part[t >> 6][dv] = o;
            __syncthreads();
            if (t < 16) { const float tot = part[0][t] + part[1][t] + part[2][t] + part[3][t]; float* op = O + (size_t)row * GDV + h * 256 + vs * 16 + t; if (dir == 0) *op = tot; else *op += tot; }
        }
        __syncthreads();
    }
}
__global__ void k_gla_finish(const float* O, const float* Z, const float* onorm, float* A) {
    const int wid = (blockIdx.x * 256 + threadIdx.x) >> 6, lane = threadIdx.x & 63;
    const int row = wid >> 2, h = wid & 3;
    const float* o = O + (size_t)row * GDV + h * 256; float v[4]; float ss = 0.f;
    for (int j = 0; j < 4; ++j) { v[j] = o[lane + 64 * j]; ss += v[j] * v[j]; }
    for (int s = 32; s > 0; s >>= 1) ss += __shfl_xor(ss, s);
    const float rs = rsqrtf(ss * (1.f / 256.f) + EPS);
    for (int j = 0; j < 4; ++j) { const int c = lane + 64 * j; const float r = Z[(size_t)row * GIN + 2048 + h * 256 + c];
        A[(size_t)row * GDV + h * 256 + c] = v[j] * rs * onorm[c] * siluf(r); }
}

__global__ void k_rope(float* Z) {
    const size_t idx = (size_t)blockIdx.x * 256 + threadIdx.x;
    const int p = idx & 31; const int hs = (idx >> 5) % 18; const int row = (int)(idx / (32 * 18));
    const int tok = row % SEQ; const float pos = (p < 16) ? (float)(tok / GRID_W) : (float)(tok % GRID_W);
    const float inv = powf(10000.f, -(float)(p & 15) / 16.f);
    float sn, cs; sincosf(pos * inv, &sn, &cs);
    float* z = Z + (size_t)row * SQKV + hs * 64;
    const float x1 = z[p], x2 = z[p + 32];
    z[p] = x1 * cs - x2 * sn; z[p + 32] = x2 * cs + x1 * sn;
}
__global__ void __launch_bounds__(256) k_swa_attn(const float* Z, const float* sinks, float* O) {
    __shared__ float sp[4][640]; __shared__ float sq[4][64];
    const int w = threadIdx.x >> 6, lane = threadIdx.x & 63;
    const int wid = blockIdx.x * 4 + w; const int row = wid >> 4, head = wid & 15, kvh = head >> 3;
    const bool isctx = row >= MX; const int b = isctx ? (row - MX) / CTXL : row / SEQ; const int tok = isctx ? 0 : row % SEQ;
    sq[w][lane] = Z[(size_t)row * SQKV + head * 64 + lane];
    __syncthreads();
    const int lo = isctx ? 0 : max(tok - SWIN, 0), hi = isctx ? -1 : min(tok + SWIN, SEQ - 1); const int nb = hi - lo + 1; const int nk = nb + CTXL;
    float mx = sinks[head];
    for (int j = lane; j < nk; j += 64) {
        const int krow = j < nb ? b * SEQ + lo + j : MX + b * CTXL + (j - nb);
        const float* kp = Z + (size_t)krow * SQKV + 1024 + kvh * 64; float s = 0.f;
        for (int d = 0; d < 64; ++d) s += sq[w][d] * kp[d];
        s *= 0.125f; sp[w][j] = s; mx = fmaxf(mx, s);
    }
    for (int s = 32; s > 0; s >>= 1) mx = fmaxf(mx, __shfl_xor(mx, s));
    float den = 0.f;
    for (int j = lane; j < nk; j += 64) { const float p = __expf(sp[w][j] - mx); sp[w][j] = p; den += p; }
    for (int s = 32; s > 0; s >>= 1) den += __shfl_xor(den, s);
    den += __expf(sinks[head] - mx);
    __syncthreads();
    float o = 0.f;
    for (int j = 0; j < nk; ++j) { const int krow = j < nb ? b * SEQ + lo + j : MX + b * CTXL + (j - nb);
        o += sp[w][j] * Z[(size_t)krow * SQKV + 1152 + kvh * 64 + lane]; }
    O[(size_t)row * SQ + head * 64 + lane] = o / den;
}

extern "C" void kernel_launch(void* const* d_in, const int* in_sizes, int n_in, void* d_out, int out_size, void* d_ws, size_t ws_size, hipStream_t stream) {
    const float* x = (const float*)d_in[0]; const float* c = (const float*)d_in[1]; const float* ctx = (const float*)d_in[2]; const float* c_ctx = (const float*)d_in[3];
    const float* w_ada = (const float*)d_in[4]; const float* b_ada = (const float*)d_in[5]; const float* norm_mix = (const float*)d_in[6]; const float* norm_ffn = (const float*)d_in[7];
    const float* gla_w_in = (const float*)d_in[8]; const float* gla_wg = (const float*)d_in[9]; const float* gla_bg = (const float*)d_in[10]; const float* gla_w_o = (const float*)d_in[11];
    const float* gla_o_norm = (const float*)d_in[12]; const float* swa_w_qkv = (const float*)d_in[13]; const float* swa_b_qkv = (const float*)d_in[14]; const float* swa_w_o = (const float*)d_in[15];
    const float* swa_sinks = (const float*)d_in[16]; const float* ffn_w_in = (const float*)d_in[17]; const float* ffn_w_out = (const float*)d_in[18]; const float* norm_final = (const float*)d_in[19];
    float* out = (float*)d_out;
    const size_t szX = (size_t)MT * D * 4, szZ = (size_t)MT * GIN * 4, szMod = (size_t)DEPTH * 3 * 6 * D * 4;
    if (ws_size < 2 * szX + szZ + szMod + 4096) { fprintf(stderr, "ws too small: %zu\n", ws_size); return; }
    char* ws = (char*)d_ws;
    float* X = (float*)ws; float* H = (float*)(ws + szX); float* Z = (float*)(ws + 2 * szX); float* mod = (float*)(ws + 2 * szX + szZ);
    hipMemcpyAsync(X, x, (size_t)MX * D * 4, hipMemcpyDeviceToDevice, stream);
    hipMemcpyAsync(X + (size_t)MX * D, ctx, (size_t)MC * D * 4, hipMemcpyDeviceToDevice, stream);
    k_mod<<<dim3(6 * D / 256, DEPTH), 256, 0, stream>>>(c, c_ctx, w_ada, b_ada, mod);
    for (int i = 0; i < DEPTH; ++i) {
        const bool last = (i == DEPTH - 1); const int j = i / 2; const int M = last ? MX : MT;
        const float* modl = mod + (size_t)i * 3 * 6 * D;
        k_norm_mod<<<MT, 256, 0, stream>>>(X, norm_mix + i * D, modl, 0, H);
        if (i % 2 == 0) {
            k_gemm<0><<<dim3((GIN + 127) / 128, MT / 128), 256, 0, stream>>>(H, D, gla_w_in + (size_t)j * D * GIN, GIN, Z, GIN, GIN, D, nullptr, nullptr);
            k_gla_scan<<<BATCH * GH * 16, 256, 0, stream>>>(Z, gla_wg + (size_t)j * 2 * 16 * 512, gla_bg + (size_t)j * 2 * 512, H);
            k_gla_finish<<<MT * GH / 4, 256, 0, stream>>>(H, Z, gla_o_norm + j * GHV, H);
            k_gemm<1><<<dim3(D / 128, M / 128), 256, 0, stream>>>(H, D, gla_w_o + (size_t)j * GDV * D, D, X, D, D, GDV, nullptr, modl + 2 * D);
        } else {
            k_gemm<0><<<dim3(SQKV / 128, MT / 128), 256, 0, stream>>>(H, D, swa_w_qkv + (size_t)j * D * SQKV, SQKV, Z, SQKV, SQKV, D, swa_b_qkv + j * SQKV, nullptr);
            k_rope<<<(MX * 18 * 32) / 256, 256, 0, stream>>>(Z);
            k_swa_attn<<<M * SH / 4, 256, 0, stream>>>(Z, swa_sinks + j * SH, H);
            k_gemm<1><<<dim3(D / 128, M / 128), 256, 0, stream>>>(H, D, swa_w_o + (size_t)j * SQ * D, D, X, D, D, SQ, nullptr, modl + 2 * D);
        }
        k_norm_mod<<<M, 256, 0, stream>>>(X, norm_ffn + i * D, modl, 3 * D, H);
        k_gemm<2><<<dim3(FH / 128, M / 128), 256, 0, stream>>>(H, D, ffn_w_in + (size_t)i * D * 2 * FH, 2 * FH, Z, FH, FH, D, nullptr, nullptr);
        k_gemm<1><<<dim3(D / 128, M / 128), 256, 0, stream>>>(Z, FH, ffn_w_out + (size_t)i * FH * D, D, X, D, D, FH, nullptr, modl + 5 * D);
    }
    k_norm_mod<<<MX, 256, 0, stream>>>(X, norm_final, nullptr, 0, out);
}
```

```cpp
#include <hip/hip_runtime.h>
#include <cstdio>
#include <cstdint>

constexpr int D = 1024, BATCH = 2, SEQ = 8192, DEPTH = 4, CTXL = 256, GRID_W = 64;
constexpr int MX = BATCH * SEQ, MC = BATCH * CTXL, MT = MX + MC;
constexpr float EPS = 1e-6f;
constexpr int GH = 4, GDK = 512, GDV = 1024, GHK = 128, GHV = 256, GRANK = 16, GIN = 2 * GDK + 2 * GDV + 2 * GRANK;
constexpr int GINP = 3328;
constexpr int SH = 16, SKVH = 2, SHD = 64, SQ = 1024, SKVD = 128, SQKV = 1280, SWIN = 128;
constexpr int FH = 2816;
constexpr float QSCALE_GLA = 0.08838834764831845f;
constexpr float C2 = 0.125f * 1.4426950408889634f;
constexpr float LOG2E = 1.4426950408889634f;

constexpr size_t MiB = 1u << 20;
constexpr size_t WS_CTL = 0, CTL_ZERO_BYTES = 1 * MiB;
constexpr size_t WS_MOD = 1 * MiB;
constexpr size_t WS_ROPE = 2 * MiB;
constexpr size_t WS_W = 4 * MiB;
constexpr size_t SZ_WGIN = (size_t)GINP * D * 2, SZ_WGO = (size_t)D * GDV * 2, SZ_WSQKV = (size_t)SQKV * D * 2, SZ_WSO = (size_t)D * SQ * 2, SZ_WFIN = (size_t)2 * FH * D * 2, SZ_WFOUT = (size_t)D * FH * 2;
constexpr size_t WS_WGIN = WS_W, WS_WGO = WS_WGIN + 2 * SZ_WGIN, WS_WSQKV = WS_WGO + 2 * SZ_WGO, WS_WSO = WS_WSQKV + 2 * SZ_WSQKV, WS_WFIN = WS_WSO + 2 * SZ_WSO, WS_WFOUT = WS_WFIN + 4 * SZ_WFIN;
constexpr size_t WS_WEND = WS_WFOUT + 4 * SZ_WFOUT;
constexpr size_t WS_X = 96 * MiB;
constexpr size_t WS_XN = 162 * MiB;
constexpr size_t WS_MIX = 195 * MiB;
constexpr size_t WS_END = 384 * MiB;
static_assert(WS_WEND <= WS_X, "weights fit");
constexpr size_t WS_QKVR = WS_MIX;
constexpr size_t WS_GF = WS_QKVR + (size_t)MT * 3072 * 2;
constexpr size_t WS_GO = WS_GF + (size_t)MT * 32 * 4;
static_assert(WS_GO + (size_t)MT * GDV * 4 <= WS_END, "gla view");
constexpr size_t WS_SQ = WS_MIX;
constexpr size_t WS_SK = WS_SQ + (size_t)MT * SQ * 2;
constexpr size_t WS_SV = WS_SK + (size_t)MT * SKVD * 2;
constexpr size_t WS_HFF = WS_MIX;
static_assert(WS_HFF + (size_t)MT * FH * 2 <= WS_END, "ffn view");

typedef unsigned short bf16;
__device__ __forceinline__ float bf2f(bf16 v) { return __uint_as_float((unsigned)v << 16); }
__device__ __forceinline__ unsigned f2bf(float f) { unsigned u = __builtin_bit_cast(unsigned, f); return (u + 0x7fffu + ((u >> 16) & 1u)) >> 16; }
__device__ __forceinline__ unsigned pk2(float lo, float hi) { return f2bf(lo) | (f2bf(hi) << 16); }
__device__ __forceinline__ float siluf(float x) { return x / (1.f + __expf(-x)); }
__device__ __forceinline__ int rowvec(int r) { return r < MX ? r / SEQ : 2; }

namespace pg8 {
#define PG8_LAS __attribute__((address_space(3)))
typedef unsigned short bf16_t;
typedef short bf16x8 __attribute__((ext_vector_type(8)));
typedef float f32x4 __attribute__((ext_vector_type(4)));
typedef unsigned u32x4 __attribute__((ext_vector_type(4)));
constexpr int BM = 256, BK = 64, HALF = 128, HTB = HALF * BK * 2  , STAGE_BYTES = 8 * HTB, NXCD = 8, WGM = 8;

__host__ __device__ __forceinline__ int lds_byte(int r, int c) { const int st = (r >> 4) * 2 + (c >> 5), rr = r & 15, cc = c & 31, ob = rr * 64 + cc * 2; return st * 1024 + (ob ^ (((ob >> 9) & 1) << 5)); }
__host__ __device__ __forceinline__ void stage_rc(int b, int& R, int& C) { const int st = b / 1024, sb = b % 1024, swz = sb ^ (((sb >> 9) & 1) << 5); R = (st >> 1) * 16 + swz / 64; C = (st & 1) * 32 + (swz % 64) / 2; }
__host__ __device__ __forceinline__ int perm32(int rho) { const int n = rho >> 4, i = rho & 15; return 8 * (i >> 2) + 4 * n + (i & 3); }

struct Unit { int pm, pn; };
struct Gemm { const bf16_t* A; const bf16_t* Bt; int M, N, K; };

struct StaticOrder {
    int nM, nN, nwg, G, c;
    __host__ __device__ void init(int M, int N, int G_, int c_) { nM = M / BM; nN = N / BM; nwg = nM * nN; G = G_; c = c_; }
    __host__ __device__ bool next(int i, Unit& u) const {
        const long L = (long)i * G + c; if (L >= nwg) return false;
        int wgid = (int)L; { const int q = nwg / NXCD, r = nwg % NXCD, xcd = wgid % NXCD, off = wgid / NXCD; wgid = (xcd < r ? xcd * (q + 1) : r * (q + 1) + (xcd - r) * q) + off; }
        const int nig = WGM * nN, gid = wgid / nig, fm = gid * WGM, gsz = (nM - fm) < WGM ? (nM - fm) : WGM;
        u.pm = fm + ((wgid % nig) % gsz); u.pn = (wgid % nig) / gsz; return true;
    }
    __device__ __forceinline__ void a_ready(const Unit&) const {}
    __device__ __forceinline__ void done(const Unit&) const {}
};

__device__ __forceinline__ unsigned cvt_pk_bf16(float lo, float hi) { unsigned r; asm volatile("v_cvt_pk_bf16_f32 %0, %1, %2" : "=v"(r) : "v"(lo), "v"(hi)); return r; }
typedef float f32x2 __attribute__((ext_vector_type(2)));
template <class Epi, class Sched, bool ALIGN_EPI = false, bool SP2 = false>
__device__ __forceinline__ void gemm_phase(PG8_LAS unsigned char* lds, const Gemm g, const Sched& S, const Epi& E) {
    int tid = threadIdx.x; asm volatile("" : "+v"(tid));
    const int wid = __builtin_amdgcn_readfirstlane(tid >> 6), lane = tid & 63, wr = wid >> 2, wc = wid & 3, fr = lane & 15, fq = lane >> 4;
    const int K = g.K, nt = K / BK;
    unsigned voffA[2], voffB[2];
#pragma unroll
    for (int i = 0; i < 2; ++i) { int R, C; stage_rc(tid * 16 + i * 8192, R, C); const int Rb = Epi::PERM ? ((R & ~31) + perm32(R & 31)) : R;
        voffA[i] = (unsigned)(R * K + C) * 2u; voffB[i] = (unsigned)(Rb * K + C) * 2u; }
    const size_t kstep = (size_t)(BK * 2);
    const size_t hstep = (size_t)HALF * K * 2;
    const size_t tstep = 2 * hstep;
    const unsigned ldsw = (unsigned)wid * 1024u;
    const int aoff = lds_byte(wr * 64 + fr, fq * 8), boff = lds_byte(wc * 32 + fr, fq * 8);
#define PG8_SA(b, h) (((b) * 2 + (h)) * HTB)
#define PG8_SB(b, h) ((4 + (b) * 2 + (h)) * HTB)
#define PG8_STAGE(bufoff, gbase, voff) do { _Pragma("unroll") for (int _i = 0; _i < 2; ++_i) \
        __builtin_amdgcn_global_load_lds((const unsigned*)((const char*)(gbase) + (voff)[_i]), (PG8_LAS unsigned*)(lds + (bufoff) + ldsw + _i * 8192), 16, 0, 0); } while (0)
#define PG8_LDA(dst, b, h) do { _Pragma("unroll") for (int m = 0; m < 4; ++m) _Pragma("unroll") for (int k = 0; k < 2; ++k) dst[m][k] = *(const PG8_LAS bf16x8*)(lds + PG8_SA(b, h) + aoff + m * 2048 + k * 1024); } while (0)
#define PG8_LDB(dst, b, h) do { _Pragma("unroll") for (int n = 0; n < 2; ++n) _Pragma("unroll") for (int k = 0; k < 2; ++k) dst[n][k] = *(const PG8_LAS bf16x8*)(lds + PG8_SB(b, h) + boff + n * 2048 + k * 1024); } while (0)
#define PG8_MMA(ai, bj, At, Bt) do { __builtin_amdgcn_s_setprio(1); _Pragma("unroll") for (int m = 0; m < 4; ++m) _Pragma("unroll") for (int n = 0; n < 2; ++n) _Pragma("unroll") for (int k = 0; k < 2; ++k) \
        acc[ai][bj][m][n] = __builtin_amdgcn_mfma_f32_16x16x32_bf16(Bt[n][k], At[m][k], acc[ai][bj][m][n], 0, 0, 0); __builtin_amdgcn_s_setprio(0); } while (0)
#define PG8_WAIT_V(n) asm volatile("s_waitcnt vmcnt(" #n ")" ::: "memory")
#define PG8_WAIT_L(n) asm volatile("s_waitcnt lgkmcnt(" #n ")" ::: "memory")
#define PG8_BAR __builtin_amdgcn_s_barrier()
#define PG8_SCHED __builtin_amdgcn_sched_barrier(0)
    Unit cur, nxt; int ui = 0;
    if (!S.next(0, cur)) return;
    f32x4 acc[2][2][4][2];
#pragma unroll
    for (int a = 0; a < 2; ++a)
#pragma unroll
        for (int b = 0; b < 2; ++b)
#pragma unroll
            for (int m = 0; m < 4; ++m)
#pragma unroll
                for (int n = 0; n < 2; ++n) acc[a][b][m][n] = (f32x4){0.f, 0.f, 0.f, 0.f};
    bf16x8 At[4][2], B0[2][2], B1[2][2];
    const char* cA = (const char*)g.A + (size_t)cur.pm * tstep; const char* cB = (const char*)g.Bt + (size_t)cur.pn * tstep;
    S.a_ready(cur);
    if constexpr (SP2) {
        PG8_STAGE(PG8_SB(0, 0), cB, voffB); PG8_STAGE(PG8_SB(0, 1), cB + hstep, voffB); PG8_STAGE(PG8_SA(0, 0), cA, voffA); PG8_STAGE(PG8_SA(0, 1), cA + hstep, voffA);
        if (wr == 1) PG8_BAR;
        PG8_WAIT_V(2); PG8_BAR;
        PG8_STAGE(PG8_SB(1, 0), cB + kstep, voffB); PG8_STAGE(PG8_SA(1, 0), cA + kstep, voffA); PG8_STAGE(PG8_SB(1, 1), cB + hstep + kstep, voffB);
        PG8_WAIT_V(6); PG8_BAR;
    } else {
        PG8_STAGE(PG8_SB(0, 0), cB, voffB); PG8_STAGE(PG8_SA(0, 0), cA, voffA); PG8_STAGE(PG8_SB(0, 1), cB + hstep, voffB); PG8_STAGE(PG8_SA(0, 1), cA + hstep, voffA);
        if (wr == 1) PG8_BAR;
        PG8_WAIT_V(4); PG8_BAR;
        PG8_STAGE(PG8_SB(1, 0), cB + kstep, voffB); PG8_STAGE(PG8_SA(1, 0), cA + kstep, voffA); PG8_STAGE(PG8_SB(1, 1), cB + hstep + kstep, voffB);
        PG8_WAIT_V(6); PG8_BAR;
    }
    for (;;) {
        const bool has_next = S.next(ui + 1, nxt);
        const char* nA = has_next ? (const char*)g.A + (size_t)nxt.pm * tstep : cA; const char* nB = has_next ? (const char*)g.Bt + (size_t)nxt.pn * tstep : cB;
        for (int t = 0; t < nt; t += 2) {
            const bool last = (t == nt - 2);
            const char* a1 = cA + (size_t)(t + 1) * kstep;
            const char* a2 = last ? nA : cA + (size_t)(t + 2) * kstep; const char* b2 = last ? nB : cB + (size_t)(t + 2) * kstep;
            const char* a3 = a2 + kstep; const char* b3 = b2 + kstep;
            if (last && has_next) S.a_ready(nxt);
            if constexpr (SP2) {
            PG8_LDB(B0, 0, 0); PG8_LDB(B1, 0, 1); PG8_SCHED; PG8_LDA(At, 0, 0); PG8_STAGE(PG8_SA(1, 1), a1 + hstep, voffA);
            PG8_WAIT_V(8); PG8_WAIT_L(0); PG8_BAR; PG8_MMA(0, 0, At, B0); PG8_MMA(0, 1, At, B1); PG8_BAR; PG8_SCHED;
            PG8_LDA(At, 0, 1); PG8_STAGE(PG8_SB(0, 0), b2, voffB); PG8_STAGE(PG8_SB(0, 1), b2 + hstep, voffB); PG8_STAGE(PG8_SA(0, 0), a2, voffA);
            PG8_WAIT_V(8); PG8_WAIT_L(0); PG8_BAR; PG8_MMA(1, 0, At, B0); PG8_MMA(1, 1, At, B1); PG8_BAR; PG8_SCHED;
            PG8_LDB(B0, 1, 0); PG8_LDB(B1, 1, 1); PG8_SCHED; PG8_LDA(At, 1, 0); PG8_STAGE(PG8_SA(0, 1), a2 + hstep, voffA);
            PG8_WAIT_V(8); PG8_WAIT_L(0); PG8_BAR; PG8_MMA(0, 0, At, B0); PG8_MMA(0, 1, At, B1); PG8_BAR; PG8_SCHED;
            PG8_LDA(At, 1, 1); PG8_STAGE(PG8_SB(1, 0), b3, voffB); PG8_STAGE(PG8_SB(1, 1), b3 + hstep, voffB); PG8_STAGE(PG8_SA(1, 0), a3, voffA);
            PG8_WAIT_V(8); PG8_WAIT_L(0); PG8_BAR; PG8_MMA(1, 0, At, B0); PG8_MMA(1, 1, At, B1); PG8_BAR; PG8_SCHED;
            } else {
            PG8_LDB(B0, 0, 0); PG8_SCHED; PG8_LDA(At, 0, 0); PG8_STAGE(PG8_SA(1, 1), a1 + hstep, voffA);
            PG8_WAIT_L(8); PG8_BAR; PG8_WAIT_L(0); PG8_MMA(0, 0, At, B0); PG8_BAR; PG8_SCHED;
            PG8_LDB(B1, 0, 1); PG8_STAGE(PG8_SB(0, 0), b2, voffB);
            PG8_BAR; PG8_WAIT_L(0); PG8_MMA(0, 1, At, B1); PG8_BAR;
            PG8_LDA(At, 0, 1); PG8_STAGE(PG8_SA(0, 0), a2, voffA);
            PG8_BAR; PG8_WAIT_L(0); PG8_MMA(1, 0, At, B0); PG8_BAR; PG8_SCHED;
            PG8_STAGE(PG8_SB(0, 1), b2 + hstep, voffB);
            PG8_WAIT_V(6); PG8_BAR; PG8_MMA(1, 1, At, B1); PG8_BAR;
            PG8_LDB(B0, 1, 0); PG8_SCHED; PG8_LDA(At, 1, 0); PG8_STAGE(PG8_SA(0, 1), a2 + hstep, voffA);
            PG8_WAIT_L(8); PG8_BAR; PG8_WAIT_L(0); PG8_MMA(0, 0, At, B0); PG8_BAR; PG8_SCHED;
            PG8_LDB(B1, 1, 1); PG8_STAGE(PG8_SB(1, 0), b3, voffB);
            PG8_BAR; PG8_WAIT_L(0); PG8_MMA(0, 1, At, B1); PG8_BAR;
            PG8_LDA(At, 1, 1); PG8_STAGE(PG8_SA(1, 0), a3, voffA);
            PG8_BAR; PG8_WAIT_L(0); PG8_MMA(1, 0, At, B0); PG8_BAR; PG8_SCHED;
            PG8_STAGE(PG8_SB(1, 1), b3 + hstep, voffB);
            PG8_WAIT_V(6); PG8_BAR; PG8_MMA(1, 1, At, B1); PG8_BAR;
            }
        }
        if constexpr (ALIGN_EPI) { if (wr == 0) PG8_BAR; }
        if constexpr (!Epi::AFTER_DRAIN) { E(acc, cur, wr, wc, fr, fq); S.done(cur); }
        if (!has_next) break;
#pragma unroll
        for (int a = 0; a < 2; ++a)
#pragma unroll
            for (int b = 0; b < 2; ++b)
#pragma unroll
                for (int m = 0; m < 4; ++m)
#pragma unroll
                    for (int n = 0; n < 2; ++n) acc[a][b][m][n] = (f32x4){0.f, 0.f, 0.f, 0.f};
        cur = nxt; cA = nA; cB = nB; ++ui;
        if constexpr (ALIGN_EPI) { if (wr == 1) PG8_BAR; }
    }
    PG8_WAIT_V(0);
    if constexpr (!ALIGN_EPI) { if (wr == 0) PG8_BAR; }
    PG8_BAR;
    if constexpr (Epi::AFTER_DRAIN) { E.fused(acc, cur, wr, wc, fr, fq, lds, wid, lane); S.done(cur); }
#undef PG8_SA
#undef PG8_SB
#undef PG8_STAGE
#undef PG8_LDA
#undef PG8_LDB
#undef PG8_MMA
#undef PG8_WAIT_V
#undef PG8_WAIT_L
#undef PG8_BAR
#undef PG8_SCHED
}
}
using pg8::f32x4; using pg8::u32x4; using pg8::Unit; using pg8::BM; using pg8::HALF; using pg8::cvt_pk_bf16;
typedef unsigned u32x2 __attribute__((ext_vector_type(2)));
#define UNR _Pragma("unroll")
struct EpiResid {
    static constexpr bool PERM = false, AFTER_DRAIN = false;
    const float* base_lat; const float* base_ctx; float* X; const float* gate;
    __device__ __forceinline__ void operator()(const f32x4 (&acc)[2][2][4][2], const Unit& u, int wr, int wc, int fr, int fq) const {
        const int vec = u.pm < MX / BM ? (u.pm >> 5) : 2;
        const int row0 = u.pm * BM + wr * 64 + fr, col0 = u.pn * BM + wc * 32 + 4 * fq;
        const float* gp = gate + (size_t)vec * 6 * D + col0;
        f32x4 gv[2][2];
        UNR for (int bj = 0; bj < 2; ++bj) UNR for (int n = 0; n < 2; ++n) gv[bj][n] = *(const f32x4*)(gp + bj * HALF + n * 16);
        UNR for (int ai = 0; ai < 2; ++ai) UNR for (int m = 0; m < 4; ++m) {
            const int row = row0 + ai * HALF + m * 16;
            const float* bp = (row < MX ? base_lat + (size_t)row * D : base_ctx + (size_t)(row - MX) * D) + col0; float* xp = X + (size_t)row * D + col0;
            UNR for (int bj = 0; bj < 2; ++bj) UNR for (int n = 0; n < 2; ++n) { const f32x4 b = *(const f32x4*)(bp + bj * HALF + n * 16); *(f32x4*)(xp + bj * HALF + n * 16) = b + gv[bj][n] * acc[ai][bj][m][n]; }
        }
    }
};
struct EpiSwiglu {
    static constexpr bool PERM = true, AFTER_DRAIN = false;
    bf16* H;
    __device__ __forceinline__ void operator()(const f32x4 (&acc)[2][2][4][2], const Unit& u, int wr, int wc, int fr, int fq) const {
        const int row0 = u.pm * BM + wr * 64 + fr, hc0 = u.pn * 128 + wc * 16 + 4 * fq;
        UNR for (int ai = 0; ai < 2; ++ai) UNR for (int m = 0; m < 4; ++m) { bf16* rp = H + (size_t)(row0 + ai * HALF + m * 16) * FH + hc0;
            UNR for (int bj = 0; bj < 2; ++bj) { const f32x4 g = acc[ai][bj][m][0], uu = acc[ai][bj][m][1];
                u32x2 w; w.x = cvt_pk_bf16(siluf(g[0]) * uu[0], siluf(g[1]) * uu[1]); w.y = cvt_pk_bf16(siluf(g[2]) * uu[2], siluf(g[3]) * uu[3]);
                *(u32x2*)(rp + bj * 64) = w; } }
    }
};
struct EpiGlaIn {
    static constexpr bool PERM = true, AFTER_DRAIN = false;
    bf16* QKVR; float* GF;
    __device__ __forceinline__ void operator()(const f32x4 (&acc)[2][2][4][2], const Unit& u, int wr, int wc, int fr, int fq) const {
        const int row0 = u.pm * BM + wr * 64 + fr;
        if (u.pn < 12) {
            const float sc = u.pn < 2 ? QSCALE_GLA : 1.f; const int col0 = u.pn * BM + wc * 32 + 8 * fq;
            UNR for (int ai = 0; ai < 2; ++ai) UNR for (int m = 0; m < 4; ++m) { bf16* rp = QKVR + (size_t)(row0 + ai * HALF + m * 16) * 3072 + col0;
                UNR for (int bj = 0; bj < 2; ++bj) { const f32x4 v0 = acc[ai][bj][m][0] * sc, v1 = acc[ai][bj][m][1] * sc;
                    u32x4 w; w.x = cvt_pk_bf16(v0[0], v0[1]); w.y = cvt_pk_bf16(v0[2], v0[3]); w.z = cvt_pk_bf16(v1[0], v1[1]); w.w = cvt_pk_bf16(v1[2], v1[3]);
                    *(u32x4*)(rp + bj * HALF) = w; } }
        } else if (wc == 0) {
            UNR for (int ai = 0; ai < 2; ++ai) UNR for (int m = 0; m < 4; ++m) { float* gp = GF + (size_t)(row0 + ai * HALF + m * 16) * 32 + 8 * fq;
                *(f32x4*)gp = acc[ai][0][m][0]; *(f32x4*)(gp + 4) = acc[ai][0][m][1]; }
        }
    }
};
struct EpiSwaQkv {
    static constexpr bool PERM = true, AFTER_DRAIN = false;
    bf16 *Qs, *Ks, *Vs; const float* bias; const float* rope;
    __device__ __forceinline__ void operator()(const f32x4 (&acc)[2][2][4][2], const Unit& u, int wr, int wc, int fr, int fq) const {
        const int row0 = u.pm * BM + wr * 64 + fr; const bool lat = u.pm < MX / BM;
        UNR for (int bj = 0; bj < 2; ++bj) {
            const int c0 = u.pn * BM + bj * HALF + wc * 32 + 8 * fq;
            const bool isv = c0 >= SQ + SKVD; const bool isq = c0 < SQ;
            const int hs = c0 >> 6, p0 = (c0 & 63) >> 1;
            f32x4 b0, b1;
            if (isv) { b0 = *(const f32x4*)(bias + c0); b1 = *(const f32x4*)(bias + c0 + 4); }
            else { const f32x4 x1 = *(const f32x4*)(bias + hs * 64 + p0), x2 = *(const f32x4*)(bias + hs * 64 + 32 + p0); b0 = (f32x4){x1[0], x2[0], x1[1], x2[1]}; b1 = (f32x4){x1[2], x2[2], x1[3], x2[3]}; }
            bf16* ob = isq ? Qs + c0 : (isv ? Vs + (c0 - SQ - SKVD) : Ks + (c0 - SQ)); const int ld = isq ? SQ : SKVD; const float sc = isq ? C2 : 1.f;
            UNR for (int ai = 0; ai < 2; ++ai) UNR for (int m = 0; m < 4; ++m) { const int row = row0 + ai * HALF + m * 16;
                f32x4 v0 = acc[ai][bj][m][0] + b0, v1 = acc[ai][bj][m][1] + b1;
                if (lat && !isv) { const float* rp = rope + ((size_t)(row & (SEQ - 1)) * 32 + p0) * 2; const f32x4 r0 = *(const f32x4*)rp, r1 = *(const f32x4*)(rp + 4);
                    v0 = (f32x4){v0[0] * r0[0] - v0[1] * r0[1], v0[1] * r0[0] + v0[0] * r0[1], v0[2] * r0[2] - v0[3] * r0[3], v0[3] * r0[2] + v0[2] * r0[3]};
                    v1 = (f32x4){v1[0] * r1[0] - v1[1] * r1[1], v1[1] * r1[0] + v1[0] * r1[1], v1[2] * r1[2] - v1[3] * r1[3], v1[3] * r1[2] + v1[2] * r1[3]}; }
                v0 = v0 * sc; v1 = v1 * sc;
                u32x4 w; w.x = cvt_pk_bf16(v0[0], v0[1]); w.y = cvt_pk_bf16(v0[2], v0[3]); w.z = cvt_pk_bf16(v1[0], v1[1]); w.w = cvt_pk_bf16(v1[2], v1[3]);
                *(u32x4*)(ob + (size_t)row * ld) = w; }
        }
    }
};
#define LAS __attribute__((address_space(3)))
constexpr int NWAVES = 8, NTHREADS = 512;
constexpr int LDS_BYTES = 147456;
constexpr int PH_PRO = 0, PH_L0 = 1, PH_PER_LAYER = 8, PH_FIN = PH_L0 + DEPTH * PH_PER_LAYER, PH_COUNT = PH_FIN + 1;
struct Params { const float* in[20]; float* out; unsigned char* ws; int ph_lo, ph_hi; };

__device__ __forceinline__ float wave_sum(float v) {
    UNR for (int o = 1; o < 64; o <<= 1) v += __shfl_xor(v, o);
    return v;
}
__device__ __forceinline__ int srccol(int kind, int n) {
    if (kind == 1) return n < GIN ? n : -1;
    if (kind == 2) { if (n >= SQ + SKVD) return n; const int hs = n >> 6, cw = n & 63; return hs * 64 + (cw >> 1) + 32 * (cw & 1); }
    if (kind == 3) { const int m = n >> 3, s = (n >> 2) & 1, e = n & 3; return s ? FH + 4 * m + e : 4 * m + e; }
    return n;
}
__device__ __forceinline__ void transpose_item(const float* W, int K, int Nsrc, int Nnew, int kind, bf16* WT, LAS float* scr, int item, int lane) {
    const int nblk = Nnew / 32, kb = item / nblk, nb = item % nblk, k0 = 64 * kb, n0 = 32 * nb;
    const int sc = srccol(kind, n0 + (lane & 31));
#pragma unroll 8
    for (int i = 0; i < 32; ++i) { const int kk = 2 * i + (lane >> 5); scr[kk * 33 + (lane & 31)] = sc >= 0 ? W[(size_t)(k0 + kk) * Nsrc + sc] : 0.f; }
    asm volatile("s_waitcnt lgkmcnt(0)" ::: "memory");
    const int c = lane & 7;
    UNR for (int j = 0; j < 4; ++j) { const int n = (lane >> 3) + 8 * j; const LAS float* s = scr + (8 * c) * 33 + n;
        u32x4 o; o.x = pk2(s[0 * 33], s[1 * 33]); o.y = pk2(s[2 * 33], s[3 * 33]); o.z = pk2(s[4 * 33], s[5 * 33]); o.w = pk2(s[6 * 33], s[7 * 33]);
        *(u32x4*)(WT + (size_t)(n0 + n) * K + k0 + 8 * c) = o; }
    asm volatile("s_waitcnt lgkmcnt(0)" ::: "memory");
}
__device__ __forceinline__ void prologue_phase(const Params& p, LAS unsigned char* lds, int tid, int lane, int wave, int G) {
    unsigned char* ws = p.ws;
    {
        LAS float* scr = (LAS float*)(lds + wave * 16384);
        const int gw = blockIdx.x * NWAVES + wave, NGW = G * NWAVES;
        constexpr int I_GIN = (D / 64) * (GINP / 32), I_GO = (GDV / 64) * (D / 32), I_SQKV = (D / 64) * (SQKV / 32), I_SO = (SQ / 64) * (D / 32), I_FIN = (D / 64) * (2 * FH / 32), I_FOUT = (FH / 64) * (D / 32);
        constexpr int NITEMS = 2 * (I_GIN + I_GO + I_SQKV + I_SO) + 4 * (I_FIN + I_FOUT);
        for (int it = gw; it < NITEMS; it += NGW) {
            int r = it;
            if (r < 2 * I_GIN) { const int j = r / I_GIN; transpose_item(p.in[8] + (size_t)j * D * GIN, D, GIN, GINP, 1, (bf16*)(ws + WS_WGIN + j * SZ_WGIN), scr, r % I_GIN, lane); continue; } r -= 2 * I_GIN;
            if (r < 2 * I_GO) { const int j = r / I_GO; transpose_item(p.in[11] + (size_t)j * GDV * D, GDV, D, D, 0, (bf16*)(ws + WS_WGO + j * SZ_WGO), scr, r % I_GO, lane); continue; } r -= 2 * I_GO;
            if (r < 2 * I_SQKV) { const int j = r / I_SQKV; transpose_item(p.in[13] + (size_t)j * D * SQKV, D, SQKV, SQKV, 2, (bf16*)(ws + WS_WSQKV + j * SZ_WSQKV), scr, r % I_SQKV, lane); continue; } r -= 2 * I_SQKV;
            if (r < 2 * I_SO) { const int j = r / I_SO; transpose_item(p.in[15] + (size_t)j * SQ * D, SQ, D, D, 0, (bf16*)(ws + WS_WSO + j * SZ_WSO), scr, r % I_SO, lane); continue; } r -= 2 * I_SO;
            if (r < 4 * I_FIN) { const int j = r / I_FIN; transpose_item(p.in[17] + (size_t)j * D * 2 * FH, D, 2 * FH, 2 * FH, 3, (bf16*)(ws + WS_WFIN + j * SZ_WFIN), scr, r % I_FIN, lane); continue; } r -= 4 * I_FIN;
            { const int j = r / I_FOUT; transpose_item(p.in[18] + (size_t)j * FH * D, FH, D, D, 0, (bf16*)(ws + WS_WFOUT + j * SZ_WFOUT), scr, r % I_FOUT, lane); }
        }
    }
    { float* rope = (float*)(ws + WS_ROPE);
      for (int idx = blockIdx.x * NTHREADS + tid; idx < SEQ * 32; idx += G * NTHREADS) { const int pp = idx & 31, t = idx >> 5;
          const float pos = (pp < 16) ? (float)(t / GRID_W) : (float)(t % GRID_W); const float inv = powf(10000.f, -(float)(pp & 15) / 16.f);
          float sn, cs; sincosf(pos * inv, &sn, &cs); rope[2 * idx] = cs; rope[2 * idx + 1] = sn; } }
    {
        __syncthreads();
        LAS float* sv = (LAS float*)lds;
        LAS float* red = (LAS float*)(lds + 3 * 1024 * 4);
        for (int i = tid; i < D; i += NTHREADS) { sv[i] = siluf(p.in[1][i]); sv[D + i] = siluf(p.in[1][D + i]); sv[2 * D + i] = siluf(p.in[3][i]); }
        __syncthreads();
        float* mod = (float*)(ws + WS_MOD);
        const int cl = tid & 63, kg = tid >> 6;
        for (int it = blockIdx.x; it < DEPTH * (6 * D / 64); it += G) {
            const int l = it / (6 * D / 64), e = (it % (6 * D / 64)) * 64 + cl;
            const float* w = p.in[4] + (size_t)l * D * 6 * D + (size_t)(kg * 128) * 6 * D + e;
            float a0 = 0.f, a1 = 0.f, a2 = 0.f;
#pragma unroll 8
            for (int k = 0; k < 128; ++k) { const float wv = w[(size_t)k * 6 * D]; const int kk = kg * 128 + k; a0 += sv[kk] * wv; a1 += sv[D + kk] * wv; a2 += sv[2 * D + kk] * wv; }
            red[(kg * 64 + cl) * 3 + 0] = a0; red[(kg * 64 + cl) * 3 + 1] = a1; red[(kg * 64 + cl) * 3 + 2] = a2;
            __syncthreads();
            if (tid < 192) { const int v = tid >> 6; float s = p.in[5][l * 6 * D + e]; UNR for (int g = 0; g < 8; ++g) s += red[(g * 64 + cl) * 3 + v]; mod[((size_t)l * 3 + v) * 6 * D + e] = s; }
            __syncthreads();
        }
    }
}
__device__ __forceinline__ void norm_phase(const float* src_lat, const float* src_ctx, const float* w, const float* modl, int sh_off, bf16* XNp, int M, int gw, int NGW, int lane) {
    int curvec = -1; f32x4 gg[4], sh[4];
    for (int r = gw; r < M; r += NGW) {
        const int vec = rowvec(r);
        if (vec != curvec) { curvec = vec; const float* m = modl + (size_t)vec * 6 * D + sh_off;
            UNR for (int j = 0; j < 4; ++j) { const int c = lane * 4 + 256 * j; const f32x4 wv = *(const f32x4*)(w + c), sc = *(const f32x4*)(m + D + c); gg[j] = wv * (sc + 1.f); sh[j] = *(const f32x4*)(m + c); } }
        const f32x4* x = (const f32x4*)(r < MX ? src_lat + (size_t)r * D : src_ctx + (size_t)(r - MX) * D) + lane;
        f32x4 v[4]; float s = 0.f;
        UNR for (int j = 0; j < 4; ++j) { v[j] = x[64 * j]; s += (v[j][0] * v[j][0] + v[j][1] * v[j][1]) + (v[j][2] * v[j][2] + v[j][3] * v[j][3]); }
        const float rs = rsqrtf(wave_sum(s) * (1.f / D) + EPS);
        UNR for (int j = 0; j < 4; ++j) { const f32x4 y = v[j] * rs * gg[j] + sh[j]; u32x2 o; o.x = pk2(y[0], y[1]); o.y = pk2(y[2], y[3]); *(u32x2*)(XNp + (size_t)r * D + lane * 4 + 256 * j) = o; }
    }
}
__device__ __forceinline__ void final_norm_phase(const float* X, const float* w, float* out, int gw, int NGW, int lane) {
    f32x4 wv[4];
    UNR for (int j = 0; j < 4; ++j) wv[j] = *(const f32x4*)(w + lane * 4 + 256 * j);
    for (int r = gw; r < MX; r += NGW) {
        const f32x4* x = (const f32x4*)(X + (size_t)r * D) + lane; f32x4 v[4]; float s = 0.f;
        UNR for (int j = 0; j < 4; ++j) { v[j] = x[64 * j]; s += (v[j][0] * v[j][0] + v[j][1] * v[j][1]) + (v[j][2] * v[j][2] + v[j][3] * v[j][3]); }
        const float rs = rsqrtf(wave_sum(s) * (1.f / D) + EPS);
        UNR for (int j = 0; j < 4; ++j) *((f32x4*)(out + (size_t)r * D) + lane + 64 * j) = v[j] * rs * wv[j];
    }
}

__global__ void __launch_bounds__(NTHREADS, 2) mega(Params p) {
    extern __shared__ __attribute__((aligned(16))) unsigned char lds_raw[];
    LAS unsigned char* lds = (LAS unsigned char*)lds_raw;
    const int G = gridDim.x;
    unsigned char* ws = p.ws;
    float* X = (float*)(ws + WS_X); bf16* XNp = (bf16*)(ws + WS_XN); const float* mod = (const float*)(ws + WS_MOD);
    for (int ph = p.ph_lo; ph < p.ph_hi; ++ph) {
        int tid = threadIdx.x; asm volatile("" : "+v"(tid));
        const int lane = tid & 63, wave = __builtin_amdgcn_readfirstlane(tid >> 6);
        const int gw = blockIdx.x * NWAVES + wave, NGW = G * NWAVES;
        if (ph == PH_PRO) { prologue_phase(p, lds, tid, lane, wave, G); }
        else if (ph == PH_FIN) { final_norm_phase(X, p.in[19], p.out, gw, NGW, lane); }
        else {
            const int l = (ph - PH_L0) / PH_PER_LAYER, s = (ph - PH_L0) % PH_PER_LAYER, j = l >> 1; const bool gla = (l & 1) == 0, last = (l == DEPTH - 1);
            const float* modl = mod + (size_t)l * 3 * 6 * D;
            const float* src_lat = l == 0 ? p.in[0] : X; const float* src_ctx = l == 0 ? p.in[2] : X + (size_t)MX * D;
            const int Mrows = last ? MX : MT;
            if (s == 0) { norm_phase(src_lat, src_ctx, p.in[6] + l * D, modl, 0, XNp, MT, gw, NGW, lane); }
            else if (s == 1) {
                if (gla) { pg8::Gemm g{XNp, (const bf16*)(ws + WS_WGIN + j * SZ_WGIN), MT, GINP, D}; pg8::StaticOrder S; S.init(MT, GINP, G, (int)blockIdx.x);
                    EpiGlaIn E{(bf16*)(ws + WS_QKVR), (float*)(ws + WS_GF)};
                    pg8::gemm_phase<EpiGlaIn, pg8::StaticOrder, true, true>(lds, g, S, E); }
                else { pg8::Gemm g{XNp, (const bf16*)(ws + WS_WSQKV + j * SZ_WSQKV), MT, SQKV, D}; pg8::StaticOrder S; S.init(MT, SQKV, G, (int)blockIdx.x);
                    EpiSwaQkv E{(bf16*)(ws + WS_SQ), (bf16*)(ws + WS_SK), (bf16*)(ws + WS_SV), p.in[14] + j * SQKV, (const float*)(ws + WS_ROPE)};
                    pg8::gemm_phase<EpiSwaQkv, pg8::StaticOrder, true, true>(lds, g, S, E); }
            }
            else if (s == 4) {
                pg8::Gemm g{XNp, (const bf16*)(gla ? ws + WS_WGO + j * SZ_WGO : ws + WS_WSO + j * SZ_WSO), Mrows, D, D}; pg8::StaticOrder S; S.init(Mrows, D, G, (int)blockIdx.x);
                EpiResid E{src_lat, src_ctx, X, modl + 2 * D};
                pg8::gemm_phase<EpiResid, pg8::StaticOrder, true, true>(lds, g, S, E);
            }
            else if (s == 5) { norm_phase(X, X + (size_t)MX * D, p.in[7] + l * D, modl, 3 * D, XNp, Mrows, gw, NGW, lane); }
            else if (s == 6) {
                pg8::Gemm g{XNp, (const bf16*)(ws + WS_WFIN + l * SZ_WFIN), Mrows, 2 * FH, D}; pg8::StaticOrder S; S.init(Mrows, 2 * FH, G, (int)blockIdx.x);
                EpiSwiglu E{(bf16*)(ws + WS_HFF)};
                pg8::gemm_phase<EpiSwiglu, pg8::StaticOrder, true, true>(lds, g, S, E);
            }
            else if (s == 7) {
                pg8::Gemm g{(const bf16*)(ws + WS_HFF), (const bf16*)(ws + WS_WFOUT + l * SZ_WFOUT), Mrows, D, FH}; pg8::StaticOrder S; S.init(Mrows, D, G, (int)blockIdx.x);
                EpiResid E{X, X + (size_t)MX * D, X, modl + 5 * D};
                pg8::gemm_phase<EpiResid, pg8::StaticOrder, true, true>(lds, g, S, E);
            }
        }
    }
}

__device__ __forceinline__ float logsigf(float x) { return fminf(x, 0.f) - log1pf(__expf(-fabsf(x))); }
__global__ void __launch_bounds__(256) k_gla_scan(const bf16* QKVR, const float* GF, const float* wg  , const float* bg  , float* O) {
    const int vs = blockIdx.x & 15, h = (blockIdx.x >> 4) & 3, b = blockIdx.x >> 6;
    const int t = threadIdx.x, dv = t & 15, kg = t >> 4;
    __shared__ float sq[128], sk[128], sg[128], sv[16], sgf[16], swg[16][128], sbg[128], part[4][16];
    for (int dir = 0; dir < 2; ++dir) {
        for (int i = t; i < 16 * 128; i += 256) swg[i >> 7][i & 127] = wg[((size_t)dir * 16 + (i >> 7)) * 512 + h * 128 + (i & 127)];
        if (t < 128) sbg[t] = bg[dir * 512 + h * 128 + t];
        float S[8]; for (int i = 0; i < 8; ++i) S[i] = 0.f;
        __syncthreads();
        for (int step = 0; step < CTXL + SEQ; ++step) {
            int row;
            if (step < CTXL) row = MX + b * CTXL + (dir == 0 ? step : CTXL - 1 - step);
            else { const int s2 = step - CTXL; row = b * SEQ + (dir == 0 ? s2 : SEQ - 1 - s2); }
            const bf16* z = QKVR + (size_t)row * 3072;
            if (t < 128) { sq[t] = bf2f(z[h * 128 + t]); sk[t] = bf2f(z[512 + h * 128 + t]); }
            if (t >= 128 && t < 144) sv[t - 128] = bf2f(z[1024 + h * 256 + vs * 16 + (t - 128)]);
            if (t >= 192 && t < 208) sgf[t - 192] = GF[(size_t)row * 32 + dir * 16 + (t - 192)];
            __syncthreads();
            if (t < 128) { float a = sbg[t]; for (int j = 0; j < 16; ++j) a += sgf[j] * swg[j][t]; sg[t] = __expf(logsigf(a) * (1.f / 16.f)); }
            __syncthreads();
            float o = 0.f; const float vv = sv[dv];
            for (int i = 0; i < 8; ++i) { const int dk = kg * 8 + i; S[i] = S[i] * sg[dk] + sk[dk] * vv; o += sq[dk] * S[i]; }
            o += __shfl_xor(o, 16); o += __shfl_xor(o, 32);
            if ((t & 63) < 16) part[t >> 6][dv] = o;
            __syncthreads();
            if (t < 16) { const float tot = part[0][t] + part[1][t] + part[2][t] + part[3][t]; float* op = O + (size_t)row * GDV + h * 256 + vs * 16 + t; if (dir == 0) *op = tot; else *op += tot; }
        }
        __syncthreads();
    }
}
__global__ void k_gla_finish(const float* O, const bf16* QKVR, const float* onorm, bf16* A) {
    const int wid = (blockIdx.x * 256 + threadIdx.x) >> 6, lane = threadIdx.x & 63;
    const int row = wid >> 2, h = wid & 3;
    const float* o = O + (size_t)row * GDV + h * 256; float v[4]; float ss = 0.f;
    for (int j = 0; j < 4; ++j) { v[j] = o[lane + 64 * j]; ss += v[j] * v[j]; }
    for (int s = 32; s > 0; s >>= 1) ss += __shfl_xor(ss, s);
    const float rs = rsqrtf(ss * (1.f / 256.f) + EPS);
    for (int j = 0; j < 4; ++j) { const int c = lane + 64 * j; const float r = bf2f(QKVR[(size_t)row * 3072 + 2048 + h * 256 + c]);
        A[(size_t)row * GDV + h * 256 + c] = (bf16)f2bf(v[j] * rs * onorm[c] * siluf(r)); }
}
__global__ void __launch_bounds__(256) k_swa_attn(const bf16* Qs, const bf16* Ks, const bf16* Vs, const float* sinks, bf16* O) {
    __shared__ float sp[4][640]; __shared__ float sq[4][64];
    const int w = threadIdx.x >> 6, lane = threadIdx.x & 63;
    const int wid = blockIdx.x * 4 + w; const int row = wid >> 4, head = wid & 15, kvh = head >> 3;
    const bool isctx = row >= MX; const int b = isctx ? (row - MX) / CTXL : row / SEQ; const int tok = isctx ? 0 : row % SEQ;
    sq[w][lane] = bf2f(Qs[(size_t)row * SQ + head * 64 + lane]);
    __syncthreads();
    const int lo = isctx ? 0 : max(tok - SWIN, 0), hi = isctx ? -1 : min(tok + SWIN, SEQ - 1); const int nb = hi - lo + 1; const int nk = nb + CTXL;
    const float sink2 = sinks[head] * LOG2E;
    float mx = sink2;
    for (int j = lane; j < nk; j += 64) {
        const int krow = j < nb ? b * SEQ + lo + j : MX + b * CTXL + (j - nb);
        const bf16* kp = Ks + (size_t)krow * SKVD + kvh * 64; float s = 0.f;
        for (int d = 0; d < 64; ++d) s += sq[w][d] * bf2f(kp[d]);
        sp[w][j] = s; mx = fmaxf(mx, s);
    }
    for (int s = 32; s > 0; s >>= 1) mx = fmaxf(mx, __shfl_xor(mx, s));
    float den = 0.f;
    for (int j = lane; j < nk; j += 64) { const float pe = exp2f(sp[w][j] - mx); sp[w][j] = pe; den += pe; }
    for (int s = 32; s > 0; s >>= 1) den += __shfl_xor(den, s);
    den += exp2f(sink2 - mx);
    __syncthreads();
    float o = 0.f;
    for (int j = 0; j < nk; ++j) { const int krow = j < nb ? b * SEQ + lo + j : MX + b * CTXL + (j - nb);
        o += sp[w][j] * bf2f(Vs[(size_t)krow * SKVD + kvh * 64 + lane]); }
    O[(size_t)row * SQ + head * 64 + lane] = (bf16)f2bf(o / den);
}

extern "C" void kernel_launch(void* const* d_in, const int* in_sizes, int n_in, void* d_out, int out_size, void* d_ws, size_t ws_size, hipStream_t stream) {
    static int grid = 0;
    if (grid == 0) {
        if (n_in != 20 || ws_size < WS_END || out_size != MX * D) { fprintf(stderr, "kernel_launch: unexpected problem (n_in %d, ws %zu, out %d)\n", n_in, ws_size, out_size); grid = -1; return; }
        int dev = 0, cus = 0;
        if (hipGetDevice(&dev) != hipSuccess || hipDeviceGetAttribute(&cus, hipDeviceAttributeMultiprocessorCount, dev) != hipSuccess) { grid = -1; return; }
        if (hipFuncSetAttribute((const void*)mega, hipFuncAttributeMaxDynamicSharedMemorySize, LDS_BYTES) != hipSuccess) { fprintf(stderr, "kernel_launch: hipFuncSetAttribute failed\n"); grid = -1; return; }
        grid = cus;
    }
    if (grid < 0) return;
    Params p{};
    for (int i = 0; i < 20; ++i) p.in[i] = (const float*)d_in[i];
    p.out = (float*)d_out; p.ws = (unsigned char*)d_ws;
    unsigned char* ws = (unsigned char*)d_ws;
    auto run = [&](int lo, int hi) { for (int ph = lo; ph < hi; ++ph) { p.ph_lo = ph; p.ph_hi = ph + 1; hipLaunchKernelGGL(mega, dim3(grid), dim3(NTHREADS), LDS_BYTES, stream, p); } };
    run(PH_PRO, PH_PRO + 1);
    for (int l = 0; l < DEPTH; ++l) {
        const int base = PH_L0 + l * PH_PER_LAYER, j = l >> 1; const int Mrows = (l == DEPTH - 1) ? MX : MT;
        run(base, base + 2);
        if ((l & 1) == 0) {
            k_gla_scan<<<BATCH * GH * 16, 256, 0, stream>>>((const bf16*)(ws + WS_QKVR), (const float*)(ws + WS_GF), (const float*)d_in[9] + (size_t)j * 2 * 16 * 512, (const float*)d_in[10] + (size_t)j * 2 * 512, (float*)(ws + WS_GO));
            k_gla_finish<<<MT * GH / 4, 256, 0, stream>>>((const float*)(ws + WS_GO), (const bf16*)(ws + WS_QKVR), (const float*)d_in[12] + j * GHV, (bf16*)(ws + WS_XN));
        } else {
            k_swa_attn<<<Mrows * SH / 4, 256, 0, stream>>>((const bf16*)(ws + WS_SQ), (const bf16*)(ws + WS_SK), (const bf16*)(ws + WS_SV), (const float*)d_in[16] + j * SH, (bf16*)(ws + WS_XN));
        }
        run(base + 4, base + 8);
    }
    run(PH_FIN, PH_FIN + 1);
}
```

```cpp
#include <hip/hip_runtime.h>
#include <cstdio>
#include <cstdint>
#include <hip/hip_cooperative_groups.h>
namespace cg = cooperative_groups;

constexpr int D = 1024, BATCH = 2, SEQ = 8192, DEPTH = 4, CTXL = 256, GRID_W = 64;
constexpr int MX = BATCH * SEQ, MC = BATCH * CTXL, MT = MX + MC;
constexpr float EPS = 1e-6f;
constexpr int GH = 4, GDK = 512, GDV = 1024, GHK = 128, GHV = 256, GRANK = 16, GIN = 2 * GDK + 2 * GDV + 2 * GRANK;
constexpr int GINP = 3328;
constexpr int SH = 16, SKVH = 2, SHD = 64, SQ = 1024, SKVD = 128, SQKV = 1280, SWIN = 128;
constexpr int FH = 2816;
constexpr float QSCALE_GLA = 0.08838834764831845f;
constexpr float C2 = 0.125f * 1.4426950408889634f;
constexpr float LOG2E = 1.4426950408889634f;

constexpr size_t MiB = 1u << 20;
constexpr size_t WS_CTL = 0, CTL_ZERO_BYTES = 65536;
constexpr size_t WS_MOD = 1 * MiB;
constexpr size_t WS_ROPE = 2 * MiB;
constexpr size_t WS_W = 4 * MiB;
constexpr size_t SZ_WGIN = (size_t)GINP * D * 2, SZ_WGO = (size_t)D * GDV * 2, SZ_WSQKV = (size_t)SQKV * D * 2, SZ_WSO = (size_t)D * SQ * 2, SZ_WFIN = (size_t)2 * FH * D * 2, SZ_WFOUT = (size_t)D * FH * 2;
constexpr size_t WS_WGIN = WS_W, WS_WGO = WS_WGIN + 2 * SZ_WGIN, WS_WSQKV = WS_WGO + 2 * SZ_WGO, WS_WSO = WS_WSQKV + 2 * SZ_WSQKV, WS_WFIN = WS_WSO + 2 * SZ_WSO, WS_WFOUT = WS_WFIN + 4 * SZ_WFIN;
constexpr size_t WS_WEND = WS_WFOUT + 4 * SZ_WFOUT;
constexpr size_t WS_X = 96 * MiB;
constexpr size_t WS_XN = 162 * MiB;
constexpr size_t WS_MIX = 195 * MiB;
constexpr size_t WS_END = 384 * MiB;
static_assert(WS_WEND <= WS_X, "weights fit");
constexpr size_t WS_QKVR = WS_MIX;
constexpr size_t WS_GF = WS_QKVR + (size_t)MT * 3072 * 2;
constexpr size_t WS_KIB = WS_GF + (size_t)MT * 32 * 4;
constexpr size_t WS_DEC = WS_KIB + (size_t)MT * 512 * 2;
constexpr size_t WS_LS = WS_DEC + (size_t)(MT / 64) * 4 * 2 * 128 * 4;
constexpr size_t WS_DSEG = WS_LS + (size_t)256 * 2 * 256 * 128 * 2;
constexpr size_t WS_STASH = WS_DSEG + (size_t)256 * 2 * 128 * 4;
static_assert(WS_STASH % 16 == 0 && WS_STASH + (size_t)256 * 8 * 4 * 16 * 64 * 4 <= WS_END, "gla view");
constexpr size_t WS_SQ = WS_MIX;
constexpr size_t WS_SK = WS_SQ + (size_t)MT * SQ * 2;
constexpr size_t WS_SV = WS_SK + (size_t)MT * SKVD * 2;
constexpr size_t WS_HFF = WS_MIX;
static_assert(WS_HFF + (size_t)MT * FH * 2 <= WS_END, "ffn view");

#define LAS __attribute__((address_space(3)))
typedef unsigned short bf16;
__device__ __forceinline__ float bf2f(bf16 v) { return __uint_as_float((unsigned)v << 16); }
__device__ __forceinline__ unsigned f2bf(float f) { unsigned u = __builtin_bit_cast(unsigned, f); return (u + 0x7fffu + ((u >> 16) & 1u)) >> 16; }
__device__ __forceinline__ unsigned pk2(float lo, float hi) { typedef float f2_ __attribute__((ext_vector_type(2))); typedef __bf16 b2_ __attribute__((ext_vector_type(2))); f2_ v = {lo, hi}; b2_ b = __builtin_convertvector(v, b2_); return __builtin_bit_cast(unsigned, b); }
__device__ __forceinline__ float siluf(float x) { return x * __builtin_amdgcn_rcpf(1.f + __builtin_amdgcn_exp2f(-x * 1.4426950408889634f)); }
__device__ __forceinline__ int rowvec(int r) { return r < MX ? r / SEQ : 2; }

template <int K> __device__ __forceinline__ float swz_xor(float v) { return __int_as_float(__builtin_amdgcn_ds_swizzle(__float_as_int(v), (K << 10) | 0x1f)); }
#define LDS_BARRIER() do { asm volatile("s_waitcnt lgkmcnt(0)" ::: "memory"); __builtin_amdgcn_s_barrier(); asm volatile("" ::: "memory"); } while (0)
__device__ __forceinline__ int hw_lane() { int l; asm volatile("v_mbcnt_lo_u32_b32 %0, -1, 0\n\tv_mbcnt_hi_u32_b32 %0, -1, %0" : "=v"(l)); return l; }
__device__ __forceinline__ int hw_tid(int wave_s) { return wave_s * 64 + hw_lane(); }
namespace pg8 {
#define PG8_LAS __attribute__((address_space(3)))
typedef unsigned short bf16_t;
typedef short bf16x8 __attribute__((ext_vector_type(8)));
typedef float f32x4 __attribute__((ext_vector_type(4)));
typedef unsigned u32x4 __attribute__((ext_vector_type(4)));
constexpr int BM = 256, BK = 64, HALF = 128, HTB = HALF * BK * 2  , STAGE_BYTES = 8 * HTB, NXCD = 8, WGM = 8;

__host__ __device__ __forceinline__ int lds_byte(int r, int c) { const int st = (r >> 4) * 2 + (c >> 5), rr = r & 15, cc = c & 31, ob = rr * 64 + cc * 2; return st * 1024 + (ob ^ (((ob >> 9) & 1) << 5)); }
__host__ __device__ __forceinline__ void stage_rc(int b, int& R, int& C) { const int st = b / 1024, sb = b % 1024, swz = sb ^ (((sb >> 9) & 1) << 5); R = (st >> 1) * 16 + swz / 64; C = (st & 1) * 32 + (swz % 64) / 2; }
__host__ __device__ __forceinline__ int perm32(int rho) { const int n = rho >> 4, i = rho & 15; return 8 * (i >> 2) + 4 * n + (i & 3); }

struct Unit { int pm, pn, koff; };
struct Gemm { const bf16_t* A; const bf16_t* Bt; int M, N, K, ld; };

struct StaticOrder {
    int nM, nN, nwg, G, c;
    __host__ __device__ void init(int M, int N, int G_, int c_) { nM = M / BM; nN = N / BM; nwg = nM * nN; G = G_; c = c_; }
    __host__ __device__ bool next(int i, Unit& u) const {
        const long L = (long)i * G + c; if (L >= nwg) return false;
        int wgid = (int)L; { const int q = nwg / NXCD, r = nwg % NXCD, xcd = wgid % NXCD, off = wgid / NXCD; wgid = (xcd < r ? xcd * (q + 1) : r * (q + 1) + (xcd - r) * q) + off; }
        const int nig = WGM * nN, gid = wgid / nig, fm = gid * WGM, gsz = (nM - fm) < WGM ? (nM - fm) : WGM;
        u.pm = fm + ((wgid % nig) % gsz); u.pn = (wgid % nig) / gsz; u.koff = 0; return true;
    }
    __device__ __forceinline__ void a_ready(const Unit&) const {}
    __device__ __forceinline__ void done(const Unit&) const {}
};

struct SplitOrder {
    int S, kbytes, c;
    __device__ bool next(int i, Unit& u) const { if (i > 0 || c >= 8 * S) return false; const int t = c / S; u.pm = 64 + (t >> 2); u.pn = t & 3; u.koff = (c % S) * kbytes; return true; }
    __device__ __forceinline__ void a_ready(const Unit&) const {}
    __device__ __forceinline__ void done(const Unit&) const {}
};
__device__ __forceinline__ unsigned cvt_pk_bf16(float lo, float hi) { typedef float f2_ __attribute__((ext_vector_type(2))); typedef __bf16 b2_ __attribute__((ext_vector_type(2))); f2_ v = {lo, hi}; b2_ b = __builtin_convertvector(v, b2_); return __builtin_bit_cast(unsigned, b); }
typedef float f32x2 __attribute__((ext_vector_type(2)));
template <class Epi, class Sched, bool ALIGN_EPI = false, bool SP2 = false>
__device__ __forceinline__ void gemm_phase(PG8_LAS unsigned char* lds, const Gemm g, const Sched& S, const Epi& E, int wave_s) {
    int tid = hw_tid(wave_s); asm volatile("" : "+v"(tid));
    const int wid = __builtin_amdgcn_readfirstlane(tid >> 6), lane = tid & 63, wr = wid >> 2, wc = wid & 3, fr = lane & 15, fq = lane >> 4;
    const int K = g.ld, nt = g.K / BK;
    unsigned voffA[2], voffB[2];
#pragma unroll
    for (int i = 0; i < 2; ++i) { int R, C; stage_rc(tid * 16 + i * 8192, R, C); const int Rb = Epi::PERM ? ((R & ~31) + perm32(R & 31)) : R;
        voffA[i] = (unsigned)(R * K + C) * 2u; voffB[i] = (unsigned)(Rb * K + C) * 2u; }
    const size_t kstep = (size_t)(BK * 2);
    const size_t hstep = (size_t)HALF * K * 2;
    const size_t tstep = 2 * hstep;
    const unsigned ldsw = (unsigned)wid * 1024u;
    const int aoff = lds_byte(wr * 64 + fr, fq * 8), boff = lds_byte(wc * 32 + fr, fq * 8);
#define PG8_SA(b, h) (((b) * 2 + (h)) * HTB)
#define PG8_SB(b, h) ((4 + (b) * 2 + (h)) * HTB)
#define PG8_STAGE(bufoff, gbase, voff) do { _Pragma("unroll") for (int _i = 0; _i < 2; ++_i) \
        __builtin_amdgcn_global_load_lds((const unsigned*)((const char*)(gbase) + (voff)[_i]), (PG8_LAS unsigned*)(lds + (bufoff) + ldsw + _i * 8192), 16, 0, 0); } while (0)
#define PG8_LDA(dst, b, h) do { _Pragma("unroll") for (int m = 0; m < 4; ++m) _Pragma("unroll") for (int k = 0; k < 2; ++k) dst[m][k] = *(const PG8_LAS bf16x8*)(lds + PG8_SA(b, h) + aoff + m * 2048 + k * 1024); } while (0)
#define PG8_LDB(dst, b, h) do { _Pragma("unroll") for (int n = 0; n < 2; ++n) _Pragma("unroll") for (int k = 0; k < 2; ++k) dst[n][k] = *(const PG8_LAS bf16x8*)(lds + PG8_SB(b, h) + boff + n * 2048 + k * 1024); } while (0)
#define PG8_MMA(ai, bj, At, Bt) do { __builtin_amdgcn_s_setprio(1); _Pragma("unroll") for (int m = 0; m < 4; ++m) _Pragma("unroll") for (int n = 0; n < 2; ++n) _Pragma("unroll") for (int k = 0; k < 2; ++k) \
        acc[ai][bj][m][n] = __builtin_amdgcn_mfma_f32_16x16x32_bf16(Bt[n][k], At[m][k], acc[ai][bj][m][n], 0, 0, 0); __builtin_amdgcn_s_setprio(0); } while (0)
#define PG8_WAIT_V(n) asm volatile("s_waitcnt vmcnt(" #n ")" ::: "memory")
#define PG8_WAIT_L(n) asm volatile("s_waitcnt lgkmcnt(" #n ")" ::: "memory")
#define PG8_BAR __builtin_amdgcn_s_barrier()
#define PG8_SCHED __builtin_amdgcn_sched_barrier(0)
    Unit cur, nxt; int ui = 0;
    if (!S.next(0, cur)) return;
    f32x4 acc[2][2][4][2];
#pragma unroll
    for (int a = 0; a < 2; ++a)
#pragma unroll
        for (int b = 0; b < 2; ++b)
#pragma unroll
            for (int m = 0; m < 4; ++m)
#pragma unroll
                for (int n = 0; n < 2; ++n) acc[a][b][m][n] = (f32x4){0.f, 0.f, 0.f, 0.f};
    bf16x8 At[4][2], B0[2][2], B1[2][2];
    const char* cA = (const char*)g.A + (size_t)cur.pm * tstep + cur.koff; const char* cB = (const char*)g.Bt + (size_t)cur.pn * tstep + cur.koff;
    asm volatile("" : "+s"(cA), "+s"(cB));
    S.a_ready(cur);
    if constexpr (SP2) {
        PG8_STAGE(PG8_SB(0, 0), cB, voffB); PG8_STAGE(PG8_SB(0, 1), cB + hstep, voffB); PG8_STAGE(PG8_SA(0, 0), cA, voffA); PG8_STAGE(PG8_SA(0, 1), cA + hstep, voffA);
        if (wr == 1) PG8_BAR;
        PG8_WAIT_V(2); PG8_BAR;
        PG8_STAGE(PG8_SB(1, 0), cB + kstep, voffB); PG8_STAGE(PG8_SA(1, 0), cA + kstep, voffA); PG8_STAGE(PG8_SB(1, 1), cB + hstep + kstep, voffB);
        PG8_WAIT_V(6); PG8_BAR;
    } else {
        PG8_STAGE(PG8_SB(0, 0), cB, voffB); PG8_STAGE(PG8_SA(0, 0), cA, voffA); PG8_STAGE(PG8_SB(0, 1), cB + hstep, voffB); PG8_STAGE(PG8_SA(0, 1), cA + hstep, voffA);
        if (wr == 1) PG8_BAR;
        PG8_WAIT_V(4); PG8_BAR;
        PG8_STAGE(PG8_SB(1, 0), cB + kstep, voffB); PG8_STAGE(PG8_SA(1, 0), cA + kstep, voffA); PG8_STAGE(PG8_SB(1, 1), cB + hstep + kstep, voffB);
        PG8_WAIT_V(6); PG8_BAR;
    }
    for (;;) {
        const bool has_next = S.next(ui + 1, nxt);
        const char* nA = has_next ? (const char*)g.A + (size_t)nxt.pm * tstep + nxt.koff : cA; const char* nB = has_next ? (const char*)g.Bt + (size_t)nxt.pn * tstep + nxt.koff : cB;
        asm volatile("" : "+s"(nA), "+s"(nB));
        for (int t = 0; t < nt; t += 2) {
            const bool last = (t == nt - 2);
            const char* a1 = cA + (size_t)(t + 1) * kstep;
            const char* a2 = last ? nA : cA + (size_t)(t + 2) * kstep; const char* b2 = last ? nB : cB + (size_t)(t + 2) * kstep;
            const char* a3 = a2 + kstep; const char* b3 = b2 + kstep;
            if (last && has_next) S.a_ready(nxt);
            if constexpr (SP2) {
            PG8_LDB(B0, 0, 0); PG8_LDB(B1, 0, 1); PG8_SCHED; PG8_LDA(At, 0, 0); PG8_STAGE(PG8_SA(1, 1), a1 + hstep, voffA);
            PG8_WAIT_V(8); PG8_WAIT_L(0); PG8_BAR; PG8_MMA(0, 0, At, B0); PG8_MMA(0, 1, At, B1); PG8_BAR; PG8_SCHED;
            PG8_LDA(At, 0, 1); PG8_STAGE(PG8_SB(0, 0), b2, voffB); PG8_STAGE(PG8_SB(0, 1), b2 + hstep, voffB); PG8_STAGE(PG8_SA(0, 0), a2, voffA);
            PG8_WAIT_V(8); PG8_WAIT_L(0); PG8_BAR; PG8_MMA(1, 0, At, B0); PG8_MMA(1, 1, At, B1); PG8_BAR; PG8_SCHED;
            PG8_LDB(B0, 1, 0); PG8_LDB(B1, 1, 1); PG8_SCHED; PG8_LDA(At, 1, 0); PG8_STAGE(PG8_SA(0, 1), a2 + hstep, voffA);
            PG8_WAIT_V(8); PG8_WAIT_L(0); PG8_BAR; PG8_MMA(0, 0, At, B0); PG8_MMA(0, 1, At, B1); PG8_BAR; PG8_SCHED;
            PG8_LDA(At, 1, 1); PG8_STAGE(PG8_SB(1, 0), b3, voffB); PG8_STAGE(PG8_SB(1, 1), b3 + hstep, voffB); PG8_STAGE(PG8_SA(1, 0), a3, voffA);
            PG8_WAIT_V(8); PG8_WAIT_L(0); PG8_BAR; PG8_MMA(1, 0, At, B0); PG8_MMA(1, 1, At, B1); PG8_BAR; PG8_SCHED;
            } else {
            PG8_LDB(B0, 0, 0); PG8_SCHED; PG8_LDA(At, 0, 0); PG8_STAGE(PG8_SA(1, 1), a1 + hstep, voffA);
            PG8_WAIT_L(8); PG8_BAR; PG8_WAIT_L(0); PG8_MMA(0, 0, At, B0); PG8_BAR; PG8_SCHED;
            PG8_LDB(B1, 0, 1); PG8_STAGE(PG8_SB(0, 0), b2, voffB);
            PG8_BAR; PG8_WAIT_L(0); PG8_MMA(0, 1, At, B1); PG8_BAR;
            PG8_LDA(At, 0, 1); PG8_STAGE(PG8_SA(0, 0), a2, voffA);
            PG8_BAR; PG8_WAIT_L(0); PG8_MMA(1, 0, At, B0); PG8_BAR; PG8_SCHED;
            PG8_STAGE(PG8_SB(0, 1), b2 + hstep, voffB);
            PG8_WAIT_V(6); PG8_BAR; PG8_MMA(1, 1, At, B1); PG8_BAR;
            PG8_LDB(B0, 1, 0); PG8_SCHED; PG8_LDA(At, 1, 0); PG8_STAGE(PG8_SA(0, 1), a2 + hstep, voffA);
            PG8_WAIT_L(8); PG8_BAR; PG8_WAIT_L(0); PG8_MMA(0, 0, At, B0); PG8_BAR; PG8_SCHED;
            PG8_LDB(B1, 1, 1); PG8_STAGE(PG8_SB(1, 0), b3, voffB);
            PG8_BAR; PG8_WAIT_L(0); PG8_MMA(0, 1, At, B1); PG8_BAR;
            PG8_LDA(At, 1, 1); PG8_STAGE(PG8_SA(1, 0), a3, voffA);
            PG8_BAR; PG8_WAIT_L(0); PG8_MMA(1, 0, At, B0); PG8_BAR; PG8_SCHED;
            PG8_STAGE(PG8_SB(1, 1), b3 + hstep, voffB);
            PG8_WAIT_V(6); PG8_BAR; PG8_MMA(1, 1, At, B1); PG8_BAR;
            }
        }
        if constexpr (ALIGN_EPI) { if (wr == 0) PG8_BAR; }
        if constexpr (!Epi::AFTER_DRAIN) { E(acc, cur, wr, wc, fr, fq); S.done(cur); }
        if (!has_next) break;
#pragma unroll
        for (int a = 0; a < 2; ++a)
#pragma unroll
            for (int b = 0; b < 2; ++b)
#pragma unroll
                for (int m = 0; m < 4; ++m)
#pragma unroll
                    for (int n = 0; n < 2; ++n) acc[a][b][m][n] = (f32x4){0.f, 0.f, 0.f, 0.f};
        cur = nxt; cA = nA; cB = nB; ++ui;
        if constexpr (ALIGN_EPI) { if (wr == 1) PG8_BAR; }
    }
    PG8_WAIT_V(0);
    if constexpr (!ALIGN_EPI) { if (wr == 0) PG8_BAR; }
    PG8_BAR;
    if constexpr (Epi::AFTER_DRAIN) { E.fused(acc, cur, wr, wc, fr, fq, lds, wid, lane); S.done(cur); }
#undef PG8_SA
#undef PG8_SB
#undef PG8_STAGE
#undef PG8_LDA
#undef PG8_LDB
#undef PG8_MMA
#undef PG8_WAIT_V
#undef PG8_WAIT_L
#undef PG8_BAR
#undef PG8_SCHED
}
}
using pg8::f32x4; using pg8::u32x4; using pg8::Unit; using pg8::BM; using pg8::HALF; using pg8::cvt_pk_bf16;
typedef unsigned u32x2 __attribute__((ext_vector_type(2)));
#define UNR _Pragma("unroll")
struct EpiResid {
    static constexpr bool PERM = false, AFTER_DRAIN = false;
    const float* base_f32; bf16* Xb; const float* gate;
    __device__ __forceinline__ void operator()(const f32x4 (&acc)[2][2][4][2], const Unit& u, int wr, int wc, int fr, int fq) const {
        asm volatile("" : "+v"(fr), "+v"(fq));
        const int vec = u.pm >> 5;
        const int row0 = u.pm * BM + wr * 64 + fr, col0 = u.pn * BM + wc * 32 + 4 * fq;
        const float* gp = gate + (size_t)vec * 6 * D + col0;
        f32x4 gv[2][2];
        UNR for (int bj = 0; bj < 2; ++bj) UNR for (int n = 0; n < 2; ++n) gv[bj][n] = *(const f32x4*)(gp + bj * HALF + n * 16);
        UNR for (int ai = 0; ai < 2; ++ai) UNR for (int m = 0; m < 4; ++m) {
            const size_t off = (size_t)(row0 + ai * HALF + m * 16) * D + col0;
            UNR for (int bj = 0; bj < 2; ++bj) UNR for (int n = 0; n < 2; ++n) { f32x4 b;
                if (base_f32) b = *(const f32x4*)(base_f32 + off + bj * HALF + n * 16);
                else { const u32x2 w = *(const u32x2*)(Xb + off + bj * HALF + n * 16); b = (f32x4){__uint_as_float(w.x << 16), __uint_as_float(w.x & 0xffff0000u), __uint_as_float(w.y << 16), __uint_as_float(w.y & 0xffff0000u)}; }
                const f32x4 x = b + gv[bj][n] * acc[ai][bj][m][n]; u32x2 o; o.x = cvt_pk_bf16(x[0], x[1]); o.y = cvt_pk_bf16(x[2], x[3]); *(u32x2*)(Xb + off + bj * HALF + n * 16) = o; }
        }
    }
};
struct EpiSlab {
    static constexpr bool PERM = false, AFTER_DRAIN = false;
    float* slab; const float* gate; int kbytes;
    __device__ __forceinline__ void operator()(const f32x4 (&acc)[2][2][4][2], const Unit& u, int wr, int wc, int fr, int fq) const {
        asm volatile("" : "+v"(fr), "+v"(fq));
        const int row0 = u.pm * BM - MX + wr * 64 + fr, col0 = u.pn * BM + wc * 32 + 4 * fq;
        const float* gp = gate + (size_t)2 * 6 * D + col0; float* sp = slab + (size_t)(u.koff / kbytes) * MC * D;
        f32x4 gv[2][2];
        UNR for (int bj = 0; bj < 2; ++bj) UNR for (int n = 0; n < 2; ++n) gv[bj][n] = *(const f32x4*)(gp + bj * HALF + n * 16);
        UNR for (int ai = 0; ai < 2; ++ai) UNR for (int m = 0; m < 4; ++m) { float* xp = sp + (size_t)(row0 + ai * HALF + m * 16) * D + col0;
            UNR for (int bj = 0; bj < 2; ++bj) UNR for (int n = 0; n < 2; ++n) *(f32x4*)(xp + bj * HALF + n * 16) = gv[bj][n] * acc[ai][bj][m][n]; }
    }
};
struct EpiSwiglu {
    static constexpr bool PERM = true, AFTER_DRAIN = false;
    bf16* H;
    __device__ __forceinline__ void operator()(const f32x4 (&acc)[2][2][4][2], const Unit& u, int wr, int wc, int fr, int fq) const {
        asm volatile("" : "+v"(fr), "+v"(fq));
        const int row0 = u.pm * BM + wr * 64 + fr, hc0 = u.pn * 128 + wc * 16 + 4 * fq;
        UNR for (int ai = 0; ai < 2; ++ai) UNR for (int m = 0; m < 4; ++m) { bf16* rp = H + (size_t)(row0 + ai * HALF + m * 16) * FH + hc0;
            UNR for (int bj = 0; bj < 2; ++bj) { const f32x4 g = acc[ai][bj][m][0], uu = acc[ai][bj][m][1];
                u32x2 w; w.x = cvt_pk_bf16(siluf(g[0]) * uu[0], siluf(g[1]) * uu[1]); w.y = cvt_pk_bf16(siluf(g[2]) * uu[2], siluf(g[3]) * uu[3]);
                *(u32x2*)(rp + bj * 64) = w; } }
    }
};
struct EpiGlaIn {
    static constexpr bool PERM = true, AFTER_DRAIN = false;
    bf16* QKVR; float* GF;
    __device__ __forceinline__ void operator()(const f32x4 (&acc)[2][2][4][2], const Unit& u, int wr, int wc, int fr, int fq) const {
        asm volatile("" : "+v"(fr), "+v"(fq));
        const int row0 = u.pm * BM + wr * 64 + fr;
        if (u.pn < 12) {
            const float sc = u.pn < 2 ? QSCALE_GLA : 1.f; const int col0 = u.pn * BM + wc * 32 + 8 * fq;
            UNR for (int ai = 0; ai < 2; ++ai) UNR for (int m = 0; m < 4; ++m) { bf16* rp = QKVR + (size_t)(row0 + ai * HALF + m * 16) * 3072 + col0;
                UNR for (int bj = 0; bj < 2; ++bj) { const f32x4 v0 = acc[ai][bj][m][0] * sc, v1 = acc[ai][bj][m][1] * sc;
                    u32x4 w; w.x = cvt_pk_bf16(v0[0], v0[1]); w.y = cvt_pk_bf16(v0[2], v0[3]); w.z = cvt_pk_bf16(v1[0], v1[1]); w.w = cvt_pk_bf16(v1[2], v1[3]);
                    *(u32x4*)(rp + bj * HALF) = w; } }
        } else if (wc == 0) {
            UNR for (int ai = 0; ai < 2; ++ai) UNR for (int m = 0; m < 4; ++m) { float* gp = GF + (size_t)(row0 + ai * HALF + m * 16) * 32 + 8 * fq;
                *(f32x4*)gp = acc[ai][0][m][0]; *(f32x4*)(gp + 4) = acc[ai][0][m][1]; }
        }
    }
};
struct EpiSwaQkv {
    static constexpr bool PERM = true, AFTER_DRAIN = false;
    bf16 *Qs, *Ks, *Vs; const float* bias; const float* rope;
    __device__ __forceinline__ void operator()(const f32x4 (&acc)[2][2][4][2], const Unit& u, int wr, int wc, int fr, int fq) const {
        asm volatile("" : "+v"(fr), "+v"(fq));
        const int row0 = u.pm * BM + wr * 64 + fr; const bool lat = u.pm < MX / BM;
        UNR for (int bj = 0; bj < 2; ++bj) {
            const int c0 = u.pn * BM + bj * HALF + wc * 32 + 8 * fq;
            const bool isv = c0 >= SQ + SKVD; const bool isq = c0 < SQ;
            const int hs = c0 >> 6, p0 = (c0 & 63) >> 1;
            f32x4 b0, b1;
            if (isv) { b0 = *(const f32x4*)(bias + c0); b1 = *(const f32x4*)(bias + c0 + 4); }
            else { const f32x4 x1 = *(const f32x4*)(bias + hs * 64 + p0), x2 = *(const f32x4*)(bias + hs * 64 + 32 + p0); b0 = (f32x4){x1[0], x2[0], x1[1], x2[1]}; b1 = (f32x4){x1[2], x2[2], x1[3], x2[3]}; }
            bf16* ob = isq ? Qs + c0 : (isv ? Vs + (c0 - SQ - SKVD) : Ks + (c0 - SQ)); const int ld = isq ? SQ : SKVD; const float sc = isq ? C2 : 1.f;
            UNR for (int ai = 0; ai < 2; ++ai) UNR for (int m = 0; m < 4; ++m) { const int row = row0 + ai * HALF + m * 16;
                f32x4 v0 = acc[ai][bj][m][0] + b0, v1 = acc[ai][bj][m][1] + b1;
                if (lat && !isv) { const float* rp = rope + ((size_t)(row & (SEQ - 1)) * 32 + p0) * 2; const f32x4 r0 = *(const f32x4*)rp, r1 = *(const f32x4*)(rp + 4);
                    v0 = (f32x4){v0[0] * r0[0] - v0[1] * r0[1], v0[1] * r0[0] + v0[0] * r0[1], v0[2] * r0[2] - v0[3] * r0[3], v0[3] * r0[2] + v0[2] * r0[3]};
                    v1 = (f32x4){v1[0] * r1[0] - v1[1] * r1[1], v1[1] * r1[0] + v1[0] * r1[1], v1[2] * r1[2] - v1[3] * r1[3], v1[3] * r1[2] + v1[2] * r1[3]}; }
                v0 = v0 * sc; v1 = v1 * sc;
                u32x4 w; w.x = cvt_pk_bf16(v0[0], v0[1]); w.y = cvt_pk_bf16(v0[2], v0[3]); w.z = cvt_pk_bf16(v1[0], v1[1]); w.w = cvt_pk_bf16(v1[2], v1[3]);
                *(u32x4*)(ob + (size_t)row * ld) = w; }
        }
    }
};
typedef short bf16x8_t __attribute__((ext_vector_type(8)));
typedef short s16x4_t __attribute__((ext_vector_type(4)));
typedef float f32x16_t __attribute__((ext_vector_type(16)));
__device__ __forceinline__ s16x4_t lds_tr16(LAS const unsigned char* p) { return __builtin_bit_cast(s16x4_t, __builtin_amdgcn_ds_read_tr16_b64_v4i16((LAS s16x4_t*)p)); }
__device__ __forceinline__ float halves_max(float v) { auto rr = __builtin_amdgcn_permlane32_swap(__float_as_uint(v), __float_as_uint(v), false, false); return fmaxf(__uint_as_float(rr[0]), __uint_as_float(rr[1])); }
__device__ __forceinline__ float halves_sum(float v) { auto rr = __builtin_amdgcn_permlane32_swap(__float_as_uint(v), __float_as_uint(v), false, false); return __uint_as_float(rr[0]) + __uint_as_float(rr[1]); }
__device__ __forceinline__ unsigned cvtpk(float lo, float hi) { typedef float f2 __attribute__((ext_vector_type(2))); typedef __bf16 b2 __attribute__((ext_vector_type(2))); f2 v = {lo, hi}; b2 b = __builtin_convertvector(v, b2); return __builtin_bit_cast(unsigned, b); }
constexpr int SWA_LDS_K = 0, SWA_LDS_V = 8192;

__device__ __forceinline__ void swa_step(const bf16x8_t (&kf)[2][4], const bf16x8_t (&qf)[4], float& m, float& l, f32x16_t (&o)[2], LAS const unsigned char* vp, int mode, int qq, int hi) {
    f32x16_t sA = {}, sB = {};
    UNR for (int s = 0; s < 4; ++s) { sA = __builtin_amdgcn_mfma_f32_32x32x16_bf16(kf[0][s], qf[s], sA, 0, 0, 0); sB = __builtin_amdgcn_mfma_f32_32x32x16_bf16(kf[1][s], qf[s], sB, 0, 0, 0); }
    if (mode != 0) {
        UNR for (int r = 0; r < 16; ++r) { const int kk = (r & 3) + 8 * (r >> 2) + 4 * hi;
            const bool va = mode == 1 ? (kk >= qq) : (kk <= qq), vb = mode == 1 ? (kk + 32 >= qq) : (kk + 32 <= qq);
            sA[r] = va ? sA[r] : -1e30f; sB[r] = vb ? sB[r] : -1e30f; }
    }
    float rm = fmaxf(sA[0], sB[0]);
    UNR for (int r = 1; r < 16; ++r) rm = fmaxf(rm, fmaxf(sA[r], sB[r]));
    rm = halves_max(rm);
    if (__any(rm > m)) {
        const float mn = fmaxf(m, rm), alpha = __builtin_amdgcn_exp2f(m - mn); m = mn; l *= alpha;
        UNR for (int r = 0; r < 16; ++r) { o[0][r] *= alpha; o[1][r] *= alpha; }
    }
    float ps = 0.f;
    UNR for (int r = 0; r < 16; ++r) { sA[r] = __builtin_amdgcn_exp2f(sA[r] - m); sB[r] = __builtin_amdgcn_exp2f(sB[r] - m); ps += sA[r] + sB[r]; }
    l += ps;
    UNR for (int s = 0; s < 4; ++s) {
        const int rb = 8 * (s & 1);
        union { unsigned u[4]; bf16x8_t v; } pf;
        if (s < 2) { pf.u[0] = cvtpk(sA[rb], sA[rb + 1]); pf.u[1] = cvtpk(sA[rb + 2], sA[rb + 3]); pf.u[2] = cvtpk(sA[rb + 4], sA[rb + 5]); pf.u[3] = cvtpk(sA[rb + 6], sA[rb + 7]); }
        else       { pf.u[0] = cvtpk(sB[rb], sB[rb + 1]); pf.u[1] = cvtpk(sB[rb + 2], sB[rb + 3]); pf.u[2] = cvtpk(sB[rb + 4], sB[rb + 5]); pf.u[3] = cvtpk(sB[rb + 6], sB[rb + 7]); }
        UNR for (int dt = 0; dt < 2; ++dt) {
            const s16x4_t lo = lds_tr16(vp + dt * 4096 + s * 1024), hh = lds_tr16(vp + dt * 4096 + s * 1024 + 512);
            const bf16x8_t vf = {lo[0], lo[1], lo[2], lo[3], hh[0], hh[1], hh[2], hh[3]};
            o[dt] = __builtin_amdgcn_mfma_f32_32x32x16_bf16(vf, pf.v, o[dt], 0, 0, 0);
        }
    }
}
__device__ __forceinline__ void swa_store(const f32x16_t (&o)[2], float m, float l, float sink2, bf16* op  , int hi) {
    const float lt = halves_sum(l) + __builtin_amdgcn_exp2f(sink2 - m), inv = 1.f / lt;
    UNR for (int dt = 0; dt < 2; ++dt) UNR for (int i = 0; i < 4; ++i) { u32x2 w; w.x = cvtpk(o[dt][4 * i] * inv, o[dt][4 * i + 1] * inv); w.y = cvtpk(o[dt][4 * i + 2] * inv, o[dt][4 * i + 3] * inv);
        *(u32x2*)(op + 32 * dt + 8 * i + 4 * hi) = w; }
}
__device__ __forceinline__ void swa_phase(const bf16* Qs, const bf16* Ks, const bf16* Vs, const float* sinks, bf16* Out, bool with_ctx, LAS unsigned char* lds, int tid) {
    const int lane = tid & 63, wave = __builtin_amdgcn_readfirstlane(tid >> 6), r32 = lane & 31, hi = lane >> 5;
    const int nitems = 512 + (with_ctx ? 32 : 0);
    LAS const unsigned char* vp = lds + SWA_LDS_V + ((lane >> 4) & 1) * 32 + (lane & 3) * 8 + (4 * hi + ((lane & 15) >> 2)) * 64;
    const int skey = tid >> 3, sch = tid & 7;
    for (int item = blockIdx.x; item < nitems; item += gridDim.x) {
        int b, kvh, qrow0, nqt, kt_lo, kt_hi, tok0;
        if (item < 512) { b = item >> 8; kvh = (item >> 7) & 1; const int n2 = item & 127; nqt = 2; tok0 = 64 * n2; qrow0 = b * SEQ + tok0; kt_lo = n2 < 2 ? 2 - n2 : 0; kt_hi = n2 > 125 ? 129 - n2 : 4; }
        else { const int c = item - 512; b = c >> 4; kvh = (c >> 3) & 1; nqt = 1; tok0 = 0; qrow0 = MX + b * CTXL + 32 * (c & 7); kt_lo = 5; kt_hi = 4; }
        const int head = kvh * 8 + wave; const float sink2 = sinks[head] * LOG2E;
        bf16x8_t qf[2][4];
        UNR for (int qt = 0; qt < 2; ++qt) UNR for (int s = 0; s < 4; ++s) qf[qt][s] = *(const bf16x8_t*)(Qs + (size_t)(qrow0 + (qt < nqt ? 32 * qt : 0) + r32) * SQ + head * 64 + 16 * s + 8 * hi);
        float m[2] = {sink2, sink2}, l[2] = {0.f, 0.f}; f32x16_t o[2][2] = {};
        const int ntiles = (kt_hi - kt_lo + 1) + 4;
        auto tile_row = [&](int ti) -> int { const int kt = kt_lo + ti; return kt <= kt_hi ? b * SEQ + tok0 - 128 + 64 * kt : MX + b * CTXL + 64 * (kt - kt_hi - 1); };
        u32x4 kreg, vreg;
        { const int kr = tile_row(0) + skey; kreg = *(const u32x4*)(Ks + (size_t)kr * SKVD + kvh * 64 + 8 * sch); vreg = *(const u32x4*)(Vs + (size_t)kr * SKVD + kvh * 64 + 8 * sch); }
        for (int ti = 0; ti < ntiles; ++ti) {
            LDS_BARRIER();
            *(LAS u32x4*)(lds + SWA_LDS_K + skey * 128 + ((sch ^ (skey & 7)) * 16)) = kreg;
            *(LAS u32x4*)(lds + SWA_LDS_V + (sch >> 2) * 4096 + skey * 64 + (sch & 3) * 16) = vreg;
            LDS_BARRIER();
            if (ti + 1 < ntiles) { const int kr = tile_row(ti + 1) + skey; kreg = *(const u32x4*)(Ks + (size_t)kr * SKVD + kvh * 64 + 8 * sch); vreg = *(const u32x4*)(Vs + (size_t)kr * SKVD + kvh * 64 + 8 * sch); }
            bf16x8_t kf[2][4];
            UNR for (int mt = 0; mt < 2; ++mt) UNR for (int s = 0; s < 4; ++s) { const int row = 32 * mt + r32; kf[mt][s] = *(LAS const bf16x8_t*)(lds + SWA_LDS_K + row * 128 + (((2 * s + hi) ^ (row & 7)) * 16)); }
            const int kt = kt_lo + ti; const int mode = kt == 0 ? 1 : (kt == 4 ? 2 : 0);
            const bool band = kt <= kt_hi; const int md = band ? mode : 0;
            swa_step(kf, qf[0], m[0], l[0], o[0], vp, md, r32, hi);
            if (nqt > 1) swa_step(kf, qf[1], m[1], l[1], o[1], vp, md, 32 + r32, hi);
        }
        bf16* op = Out + (size_t)(qrow0 + r32) * SQ + head * 64;
        swa_store(o[0], m[0], l[0], sink2, op, hi);
        if (nqt > 1) swa_store(o[1], m[1], l[1], sink2, op + (size_t)32 * SQ, hi);
    }
}
constexpr int GLA_NSEG = 32, GLA_ITEMS = BATCH * GH * GLA_NSEG;
__device__ __forceinline__ int seg_rowbase(int b, int sg) { return sg == 0 ? MX + b * CTXL : b * SEQ + (sg <= 4 ? (sg - 1) * 320 : 1280 + (sg - 5) * 256); }
__device__ __forceinline__ int seg_nch(int sg) { return (sg >= 1 && sg <= 4) ? 5 : 4; }
__device__ __forceinline__ float log2sig_scaled(float a) {
    const float t = -fabsf(a) * LOG2E; return (fminf(a, 0.f) * LOG2E - __builtin_amdgcn_logf(1.f + __builtin_amdgcn_exp2f(t))) * (1.f / 16.f);
}
struct GlaBufs { const bf16* QKVR; const float* GF; bf16 *QDF, *KIF, *QDB, *KIB; float* DEC; bf16* LS; float* DSEG; unsigned* STASH; };
__device__ __forceinline__ int tr_lane_off(int lane) { return ((lane >> 4) & 1) * 32 + (lane & 3) * 8 + (4 * (lane >> 5) + ((lane & 15) >> 2)) * 64; }
__device__ __forceinline__ bf16x8_t tr_frag(LAS const unsigned char* p) { const s16x4_t lo = lds_tr16(p), hh = lds_tr16(p + 512); return (bf16x8_t){lo[0], lo[1], lo[2], lo[3], hh[0], hh[1], hh[2], hh[3]}; }

constexpr int GS = 4096 + 64;
constexpr int G1_KI = 0, G1_Q = 4 * GS, G1_V = 8 * GS, G1_GFS = 16 * GS, G1_PRE = G1_GFS + 4096, G1_TOT = G1_PRE + 32768, G1_DECL = G1_TOT + 2048;
__device__ __forceinline__ void gla_g1_phase(const GlaBufs& B, const float* wg, const float* bg, LAS unsigned char* lds, int tid) {
    const int wave = __builtin_amdgcn_readfirstlane(tid >> 6);
    for (int item = blockIdx.x; item < GLA_ITEMS; item += gridDim.x) {
        const int b = item / (GH * GLA_NSEG), h = (item / GLA_NSEG) % GH, sg = item % GLA_NSEG, rb = seg_rowbase(b, sg), nch = seg_nch(sg);
        const size_t slot = (size_t)((b * GH + h) * GLA_NSEG + sg) * 2;
        f32x16_t L[4] = {};
        u32x4 pq[2], pk[2], pv[4]; f32x4 pgf = {0.f, 0.f, 0.f, 0.f};
        float wB[8], bias, Bprev = 0.f;
        auto load_w = [&](int dr) { int tt_ = tid; asm volatile("" : "+v"(tt_)); const int ln = tt_ & 63; const float* wp = wg + (size_t)dr * 16 * 512 + h * 128 + 32 * (wave & 3) + (ln & 31) + (size_t)(ln >> 5) * 512;
            UNR for (int s2 = 0; s2 < 8; ++s2) wB[s2] = wp[(size_t)(2 * s2) * 512]; bias = bg[dr * 512 + h * 128 + (tt_ & 127)]; };
        load_w(0);
        auto issue = [&](int hs) { const int dr = hs < nch ? 0 : 1, cc = dr ? 2 * nch - 1 - hs : hs, rr = rb + 64 * cc; int tt_ = tid; asm volatile("" : "+v"(tt_));
            const char* src = (const char*)(B.QKVR + (size_t)rr * 3072 + h * 128);
            UNR for (int k = 0; k < 2; ++k) { const int q = tt_ + 512 * k, tok = q >> 4, ch = q & 15; const unsigned go = (unsigned)(tok * 3072 + 8 * ch) * 2u; pq[k] = *(const u32x4*)(src + go); pk[k] = *(const u32x4*)(src + 1024 + go); }
            UNR for (int k = 0; k < 4; ++k) { const int q = tt_ + 512 * k, tok = q >> 5, ch = q & 31; pv[k] = *(const u32x4*)(src + (1024 + h * 128) * 2 + (unsigned)(tok * 3072 + 8 * ch) * 2u); }
            if (tt_ < 256) { const int tok = tt_ >> 2, part = tt_ & 3; pgf = *(const f32x4*)(B.GF + (size_t)(rr + tok) * 32 + dr * 16 + part * 4); } };
        issue(0);
#pragma unroll 1
        for (int hs = 0; hs < 2 * nch; ++hs) {
            const int dir = hs < nch ? 0 : 1, ci = dir ? 2 * nch - 1 - hs : hs, row0 = rb + 64 * ci;
            int t_ = tid; asm volatile("" : "+v"(t_));
            const int lane = t_ & 63, hi = lane >> 5, dk = t_ & 127, tq = t_ >> 7; const int troff = tr_lane_off(lane);
            unsigned lq[2], lv[4];
            UNR for (int k = 0; k < 2; ++k) { const int q = t_ + 512 * k, tok = q >> 4, ch = q & 15; lq[k] = (unsigned)((ch >> 2) * GS + tok * 64 + (ch & 3) * 16); }
            UNR for (int k = 0; k < 4; ++k) { const int q = t_ + 512 * k, tok = q >> 5, ch = q & 31; lv[k] = (unsigned)((ch >> 2) * GS + tok * 64 + (ch & 3) * 16); }
            const unsigned ltile = (unsigned)((dk >> 5) * GS + (16 * tq) * 64 + (dk & 31) * 2);
            LDS_BARRIER();
            UNR for (int k = 0; k < 2; ++k) { *(LAS u32x4*)(lds + G1_Q + lq[k]) = pq[k]; *(LAS u32x4*)(lds + G1_KI + lq[k]) = pk[k]; }
            UNR for (int k = 0; k < 4; ++k) *(LAS u32x4*)(lds + G1_V + lv[k]) = pv[k];
            if (t_ < 256) *(LAS f32x4*)(lds + G1_GFS + (t_ >> 2) * 64 + (t_ & 3) * 16) = pgf;
            LDS_BARRIER();
            if (hs == nch) load_w(1);
            if (hs + 1 < 2 * nch) issue(hs + 1);
            { f32x16_t c = {}; const LAS float* gp = (const LAS float*)(lds + G1_GFS) + (32 * (wave >> 2) + (lane & 31)) * 16 + hi;
              UNR for (int s2 = 0; s2 < 8; ++s2) c = __builtin_amdgcn_mfma_f32_32x32x2f32(gp[2 * s2], wB[s2], c, 0, 0, 0);
              LAS float* pw = (LAS float*)(lds + G1_PRE) + (32 * (wave >> 2) + 4 * hi) * 128 + 32 * (wave & 3) + (lane & 31);
              UNR for (int r = 0; r < 16; ++r) pw[((r & 3) + 8 * (r >> 2)) * 128] = c[r]; }
            LDS_BARRIER();
            float pp[16];
            UNR for (int tt = 0; tt < 16; ++tt) pp[tt] = *((const LAS float*)(lds + G1_PRE) + (16 * tq + tt) * 128 + dk) + bias;
            float run = 0.f;
            if (dir == 0) { UNR for (int tt = 0; tt < 16; ++tt) { run += log2sig_scaled(pp[tt]); pp[tt] = run; } }
            else { UNR for (int tt = 15; tt >= 0; --tt) { run += log2sig_scaled(pp[tt]); pp[tt] = run; } }
            *(LAS float*)(lds + G1_TOT + (tq * 128 + dk) * 4) = run;
            LDS_BARRIER();
            float off = 0.f, tot = 0.f;
            UNR for (int t4 = 0; t4 < 4; ++t4) { const float a = *(LAS float*)(lds + G1_TOT + (t4 * 128 + dk) * 4); tot += a; if (dir == 0 ? (t4 < tq) : (t4 > tq)) off += a; }
            { LAS unsigned char* qt = lds + G1_Q + ltile; LAS unsigned char* kt = lds + G1_KI + ltile;
              UNR for (int tt = 0; tt < 16; ++tt) { const float b2 = Bprev + off + pp[tt];
                  const float qd = bf2f(*(LAS bf16*)(qt + tt * 64)) * __builtin_amdgcn_exp2f(b2), ki = bf2f(*(LAS bf16*)(kt + tt * 64)) * __builtin_amdgcn_exp2f(-b2);
                  const unsigned pk_ = cvtpk(qd, ki);
                  *(LAS bf16*)(qt + tt * 64) = (bf16)(pk_ & 0xffffu); *(LAS bf16*)(kt + tt * 64) = (bf16)(pk_ >> 16); } }
            Bprev += tot;
            LDS_BARRIER();
            { char* oq = (char*)((dir ? B.QDB : B.QDF) + (size_t)row0 * 512 + h * 128); char* ok = (char*)((dir ? B.KIB : B.KIF) + (size_t)row0 * 512 + h * 128);
              UNR for (int k = 0; k < 2; ++k) { const int q = t_ + 512 * k, tok = q >> 4, ch = q & 15; const unsigned go = (unsigned)(tok * 512 + 8 * ch) * 2u;
                  *(u32x4*)(oq + go) = *(LAS u32x4*)(lds + G1_Q + lq[k]); *(u32x4*)(ok + go) = *(LAS u32x4*)(lds + G1_KI + lq[k]); } }
            { LAS const unsigned char* vimg = lds + G1_V + wave * GS + troff; LAS const unsigned char* kimg = lds + G1_KI + troff;
              UNR for (int s = 0; s < 4; ++s) { const bf16x8_t vf = tr_frag(vimg + s * 1024);
                  UNR for (int mt = 0; mt < 4; ++mt) { const bf16x8_t kf = tr_frag(kimg + mt * GS + s * 1024); L[mt] = __builtin_amdgcn_mfma_f32_32x32x16_bf16(kf, vf, L[mt], 0, 0, 0); } }
            }
            if (hs == nch - 1 || hs == 2 * nch - 1) {
                const float dtot = __builtin_amdgcn_exp2f(Bprev);
                if (tq == 0) { *(LAS float*)(lds + G1_DECL + dk * 4) = dtot; B.DSEG[(slot + dir) * 128 + dk] = dtot; }
                LDS_BARRIER();
                const int dv = 32 * wave + (lane & 31); bf16* lp = B.LS + ((slot + dir) * 256 + dv) * 128;
                UNR for (int mt = 0; mt < 4; ++mt) UNR for (int i4 = 0; i4 < 4; ++i4) { const f32x4 d = *(LAS const f32x4*)(lds + G1_DECL + (32 * mt + 8 * i4 + 4 * hi) * 4);
                    u32x2 w; w.x = cvtpk(L[mt][4 * i4] * d[0], L[mt][4 * i4 + 1] * d[1]); w.y = cvtpk(L[mt][4 * i4 + 2] * d[2], L[mt][4 * i4 + 3] * d[3]); *(u32x2*)(lp + 32 * mt + 8 * i4 + 4 * hi) = w;
                    L[mt][4 * i4] = 0.f; L[mt][4 * i4 + 1] = 0.f; L[mt][4 * i4 + 2] = 0.f; L[mt][4 * i4 + 3] = 0.f; }
                Bprev = 0.f; }
        }
    }
}
__device__ __forceinline__ void gla_g1c_phase(bf16* LS, const float* DSEG, int tid) {
    const int gid = blockIdx.x * 512 + tid; if (gid >= 8 * 2 * 256 * 32) return;
    const int q4 = gid & 31, dv = (gid >> 5) & 255, dir = (gid >> 13) & 1, bh = gid >> 14;
    float S[4] = {0.f, 0.f, 0.f, 0.f};
    for (int blk = 0; blk < 4; ++blk) {
        u32x2 Lr[8]; f32x4 Dr[8];
        UNR for (int k = 0; k < 8; ++k) { const int pos = blk * 8 + k; const int sg = dir == 0 ? pos : (pos == 0 ? 0 : GLA_NSEG - pos);
            const size_t slot = (size_t)(bh * GLA_NSEG + sg) * 2 + dir; Lr[k] = *(const u32x2*)(LS + (slot * 256 + dv) * 128 + 4 * q4); Dr[k] = *(const f32x4*)(DSEG + slot * 128 + 4 * q4); }
        UNR for (int k = 0; k < 8; ++k) { const int pos = blk * 8 + k; const int sg = dir == 0 ? pos : (pos == 0 ? 0 : GLA_NSEG - pos);
            const size_t slot = (size_t)(bh * GLA_NSEG + sg) * 2 + dir;
            u32x2 w; w.x = cvtpk(S[0], S[1]); w.y = cvtpk(S[2], S[3]); *(u32x2*)(LS + (slot * 256 + dv) * 128 + 4 * q4) = w;
            const float l0 = __uint_as_float(Lr[k].x << 16), l1 = __uint_as_float(Lr[k].x & 0xffff0000u), l2 = __uint_as_float(Lr[k].y << 16), l3 = __uint_as_float(Lr[k].y & 0xffff0000u);
            S[0] = Dr[k][0] * S[0] + l0; S[1] = Dr[k][1] * S[1] + l1; S[2] = Dr[k][2] * S[2] + l2; S[3] = Dr[k][3] * S[3] + l3; }
    }
}
constexpr int G2_QD = 0, G2_KI = 17408, G2_V = G2_KI + 4 * GS, G2_AM = G2_V + 8 * GS, G2_DECL = G2_AM + 8704, G2_OB = G2_DECL + 512;
__device__ __forceinline__ void gla_load_state(f32x16_t (&S)[4], const bf16* LS, size_t slot, int dv, int hi) {
    const bf16* lp = LS + (slot * 256 + dv) * 128;
    UNR for (int mt = 0; mt < 4; ++mt) UNR for (int i4 = 0; i4 < 4; ++i4) { const u32x2 w = *(const u32x2*)(lp + 32 * mt + 8 * i4 + 4 * hi);
        S[mt][4 * i4] = __uint_as_float(w.x << 16); S[mt][4 * i4 + 1] = __uint_as_float(w.x & 0xffff0000u); S[mt][4 * i4 + 2] = __uint_as_float(w.y << 16); S[mt][4 * i4 + 3] = __uint_as_float(w.y & 0xffff0000u); }
}
__device__ __forceinline__ void gla_g2_phase(const GlaBufs& B, const float* onorm, bf16* A3, LAS unsigned char* lds, int tid) {
    const int wave = __builtin_amdgcn_readfirstlane(tid >> 6);
    for (int item = blockIdx.x; item < GLA_ITEMS; item += gridDim.x) {
        const int b = item / (GH * GLA_NSEG), h = (item / GLA_NSEG) % GH, sg = item % GLA_NSEG, rb = seg_rowbase(b, sg);
        const size_t slot = (size_t)((b * GH + h) * GLA_NSEG + sg) * 2;
        f32x16_t S[4]; const int nch = seg_nch(sg);
        u32x4 pq[2], pk[2], pv[4];
        auto issue = [&](int st) { const int dr = st < nch ? 1 : 0, cc = st < nch ? nch - 1 - st : st - nch, rr = rb + 64 * cc;
            int tt_ = tid; asm volatile("" : "+v"(tt_));
            const char* qs = (const char*)((dr ? B.QDB : B.QDF) + (size_t)rr * 512 + h * 128); const char* ks = (const char*)((dr ? B.KIB : B.KIF) + (size_t)rr * 512 + h * 128);
            UNR for (int k = 0; k < 2; ++k) { const int q = tt_ + 512 * k, tok = q >> 4, ch = q & 15; const unsigned go = (unsigned)(tok * 512 + 8 * ch) * 2u; pq[k] = *(const u32x4*)(qs + go); pk[k] = *(const u32x4*)(ks + go); }
            { const char* vs = (const char*)(B.QKVR + (size_t)rr * 3072 + 1024 + h * 256);
              UNR for (int k = 0; k < 4; ++k) { const int q = tt_ + 512 * k, tok = q >> 5, ch = q & 31; pv[k] = *(const u32x4*)(vs + (unsigned)(tok * 3072 + 8 * ch) * 2u); } }
        };
        issue(0);
#pragma unroll 1
        for (int step = 0; step < 2 * nch; ++step) {
            const int dir = step < nch ? 1 : 0, ci = step < nch ? nch - 1 - step : step - nch, r0 = rb + 64 * ci;
            int t_ = tid; asm volatile("" : "+v"(t_));
            const int lane = t_ & 63, hi = lane >> 5, r32 = lane & 31, dv = 32 * wave + r32; const int troff = tr_lane_off(lane);
            unsigned lqd[2], lki[2], lv[4];
            UNR for (int k = 0; k < 2; ++k) { const int q = t_ + 512 * k, tok = q >> 4, ch = q & 15; lqd[k] = (unsigned)(tok * 272 + ch * 16); lki[k] = (unsigned)((ch >> 2) * GS + tok * 64 + (ch & 3) * 16); }
            UNR for (int k = 0; k < 4; ++k) { const int q = t_ + 512 * k, tok = q >> 5, ch = q & 31; lv[k] = (unsigned)((ch >> 2) * GS + tok * 64 + (ch & 3) * 16); }
            u32x4* stp = (u32x4*)(B.STASH + (size_t)(blockIdx.x * 8 + wave) * 4 * 16 * 64) + lane;
            if (step == 0) gla_load_state(S, B.LS, slot + 1, dv, hi);
            if (step == nch) { asm volatile("s_waitcnt vmcnt(0)" ::: "memory"); gla_load_state(S, B.LS, slot + 0, dv, hi); }
            LDS_BARRIER();
            UNR for (int k = 0; k < 2; ++k) { *(LAS u32x4*)(lds + G2_QD + lqd[k]) = pq[k]; *(LAS u32x4*)(lds + G2_KI + lki[k]) = pk[k]; }
            UNR for (int k = 0; k < 4; ++k) *(LAS u32x4*)(lds + G2_V + lv[k]) = pv[k];
            LDS_BARRIER();
            if (step + 1 < 2 * nch) issue(step + 1);
            u32x4 pst[4];
            if (dir == 0 && ci > 0) { UNR for (int q4 = 0; q4 < 4; ++q4) pst[q4] = stp[((ci - 1) * 4 + q4) * 64]; }
            u32x4 prr[4];
            if (dir == 0) { const bf16* rp0 = B.QKVR + (size_t)r0 * 3072 + 2048 + h * 256 + ((t_ >> 3) * 3072 + 32 * (t_ & 7)); UNR for (int k = 0; k < 4; ++k) prr[k] = *(const u32x4*)(rp0 + 8 * k); }
            { const int it4 = wave >> 1, l15 = lane & 15, l4 = lane >> 4; const int i = 16 * it4 + l15;
              UNR for (int jj = 0; jj < 2; ++jj) { const int jt = 2 * (wave & 1) + jj; f32x4 c = {0.f, 0.f, 0.f, 0.f};
                  const bool need = dir == 0 ? (jt <= it4) : (jt >= it4);
                  if (need) { UNR for (int s = 0; s < 4; ++s) {
                          const bf16x8_t a = *(LAS const bf16x8_t*)(lds + G2_KI + s * GS + (16 * jt + l15) * 64 + l4 * 16);
                          const bf16x8_t bq = *(LAS const bf16x8_t*)(lds + G2_QD + i * 272 + (4 * s + l4) * 16);
                          c = __builtin_amdgcn_mfma_f32_16x16x32_bf16(a, bq, c, 0, 0, 0); }
                      if (jt == it4) { UNR for (int e = 0; e < 4; ++e) { const int j = 16 * jt + 4 * l4 + e; const bool keep = dir == 0 ? (j <= i) : (j >= i); c[e] = keep ? c[e] : 0.f; } } }
                  u32x2 w; w.x = cvtpk(c[0], c[1]); w.y = cvtpk(c[2], c[3]);
                  *(LAS u32x2*)(lds + G2_AM + i * 136 + (4 * jt + l4) * 8) = w; } }
            LDS_BARRIER();
            f32x16_t o[2]; bf16x8_t vf[4];
            UNR for (int s = 0; s < 4; ++s) vf[s] = tr_frag(lds + G2_V + wave * GS + troff + s * 1024);
            UNR for (int it = 0; it < 2; ++it) { const int row = 32 * it + r32; o[it] = (f32x16_t){};
                UNR for (int s = 0; s < 4; ++s) { union { u32x2 h2[2]; bf16x8_t v; } af;
                    af.h2[0] = *(LAS const u32x2*)(lds + G2_AM + row * 136 + (4 * s + hi) * 8); af.h2[1] = *(LAS const u32x2*)(lds + G2_AM + row * 136 + (4 * s + 2 + hi) * 8);
                    o[it] = __builtin_amdgcn_mfma_f32_32x32x16_bf16(af.v, vf[s], o[it], 0, 0, 0); } }
            __builtin_amdgcn_sched_barrier(0);
            UNR for (int s8 = 0; s8 < 8; ++s8) { const int rbase = 8 * (s8 & 1); const f32x16_t& Sm = S[s8 >> 1];
                union { unsigned u[4]; bf16x8_t v; } sf; sf.u[0] = cvtpk(Sm[rbase], Sm[rbase + 1]); sf.u[1] = cvtpk(Sm[rbase + 2], Sm[rbase + 3]); sf.u[2] = cvtpk(Sm[rbase + 4], Sm[rbase + 5]); sf.u[3] = cvtpk(Sm[rbase + 6], Sm[rbase + 7]);
                UNR for (int it = 0; it < 2; ++it) { const int row = 32 * it + r32; union { u32x2 h2[2]; bf16x8_t v; } af;
                    af.h2[0] = *(LAS const u32x2*)(lds + G2_QD + row * 272 + 32 * s8 + 8 * hi); af.h2[1] = *(LAS const u32x2*)(lds + G2_QD + row * 272 + 32 * s8 + 16 + 8 * hi);
                    o[it] = __builtin_amdgcn_mfma_f32_32x32x16_bf16(af.v, sf.v, o[it], 0, 0, 0); } }
            __builtin_amdgcn_sched_barrier(0);
            UNR for (int s = 0; s < 4; ++s) { const bf16x8_t vf2 = tr_frag(lds + G2_V + wave * GS + troff + s * 1024);
                UNR for (int mt = 0; mt < 4; ++mt) { const bf16x8_t kf = tr_frag(lds + G2_KI + mt * GS + troff + s * 1024); S[mt] = __builtin_amdgcn_mfma_f32_32x32x16_bf16(kf, vf2, S[mt], 0, 0, 0); } }
            if (dir == 1) {
                if (ci == 0) { UNR for (int it = 0; it < 2; ++it) UNR for (int r = 0; r < 16; ++r) *(LAS float*)(lds + G2_OB + ((32 * it + (r & 3) + 8 * (r >> 2) + 4 * hi) * 256 + dv) * 4) = o[it][r]; }
                else { UNR for (int it = 0; it < 2; ++it) UNR for (int e4 = 0; e4 < 2; ++e4) { u32x4 w; w.x = cvtpk(o[it][8 * e4], o[it][8 * e4 + 1]); w.y = cvtpk(o[it][8 * e4 + 2], o[it][8 * e4 + 3]); w.z = cvtpk(o[it][8 * e4 + 4], o[it][8 * e4 + 5]); w.w = cvtpk(o[it][8 * e4 + 6], o[it][8 * e4 + 7]);
                    stp[((ci - 1) * 4 + it * 2 + e4) * 64] = w; } }
            } else {
                if (ci == 0) { UNR for (int it = 0; it < 2; ++it) UNR for (int r = 0; r < 16; ++r) { LAS float* ob = (LAS float*)(lds + G2_OB + ((32 * it + (r & 3) + 8 * (r >> 2) + 4 * hi) * 256 + dv) * 4); *ob = *ob + o[it][r]; } }
                else { unsigned pk[16];
                    UNR for (int q4 = 0; q4 < 4; ++q4) { const u32x4 w = pst[q4]; pk[4 * q4] = w.x; pk[4 * q4 + 1] = w.y; pk[4 * q4 + 2] = w.z; pk[4 * q4 + 3] = w.w; }
                    UNR for (int it = 0; it < 2; ++it) UNR for (int e = 0; e < 8; ++e) { const unsigned w = pk[it * 8 + e];
                        const float v0 = o[it][2 * e] + __uint_as_float(w << 16), v1 = o[it][2 * e + 1] + __uint_as_float(w & 0xffff0000u);
                        const int ra = 2 * e, rc = 2 * e + 1;
                        *(LAS float*)(lds + G2_OB + ((32 * it + (ra & 3) + 8 * (ra >> 2) + 4 * hi) * 256 + dv) * 4) = v0;
                        *(LAS float*)(lds + G2_OB + ((32 * it + (rc & 3) + 8 * (rc >> 2) + 4 * hi) * 256 + dv) * 4) = v1; } }
                LDS_BARRIER();
                { const int tok = t_ >> 3, part = t_ & 7; const LAS f32x4* op = (const LAS f32x4*)(lds + G2_OB + (tok * 256 + 32 * part) * 4);
                  float ss = 0.f;
                  UNR for (int k = 0; k < 8; ++k) { const f32x4 t = op[k]; ss += (t[0] * t[0] + t[1] * t[1]) + (t[2] * t[2] + t[3] * t[3]); }
                  ss += swz_xor<1>(ss); ss += swz_xor<2>(ss); ss += swz_xor<4>(ss);
                  const float rs = rsqrtf(ss * (1.f / 256.f) + EPS);
                  const bf16* rp = B.QKVR + (size_t)r0 * 3072 + 2048 + h * 256 + (tok * 3072 + 32 * part); bf16* ap = A3 + (size_t)r0 * GDV + h * 256 + (tok * GDV + 32 * part); const float* np_ = onorm + 32 * part;
                  UNR for (int k = 0; k < 4; ++k) { const u32x4 rw = prr[k]; const f32x4 n0 = *(const f32x4*)(np_ + 8 * k), n1 = *(const f32x4*)(np_ + 8 * k + 4); const f32x4 a0 = op[2 * k], a1 = op[2 * k + 1];
                      const unsigned rr[4] = {rw.x, rw.y, rw.z, rw.w}; float y[8];
                      UNR for (int e = 0; e < 4; ++e) { const float rl = __uint_as_float(rr[e] << 16), rh = __uint_as_float(rr[e] & 0xffff0000u);
                          const float oa = e < 2 ? a0[2 * e] : a1[2 * e - 4], ob = e < 2 ? a0[2 * e + 1] : a1[2 * e - 3]; const float na = e < 2 ? n0[2 * e] : n1[2 * e - 4], nb = e < 2 ? n0[2 * e + 1] : n1[2 * e - 3];
                          y[2 * e] = oa * rs * na * siluf(rl); y[2 * e + 1] = ob * rs * nb * siluf(rh); }
                      u32x4 w; w.x = cvtpk(y[0], y[1]); w.y = cvtpk(y[2], y[3]); w.z = cvtpk(y[4], y[5]); w.w = cvtpk(y[6], y[7]); *(u32x4*)(ap + 8 * k) = w; } }
            }
        }
    }
}
#define GAS __attribute__((address_space(1)))
#define XB_TMO      128
#define XB_XCNT(j)  (256  + 64 * (j))
#define XB_XSUB(j)  (1280 + 64 * (j))
#define XB_XGEN(j)  (2304 + 64 * (j))
#define XB_TOP      3328
#define XB_TOPGEN   3392
#define XCD_BAR_WORDS 3456
#define XB_SPIN_CAP (1u << 18)

__device__ __forceinline__ unsigned xb_ld(unsigned* p)              { return __hip_atomic_load(p, __ATOMIC_RELAXED, __HIP_MEMORY_SCOPE_AGENT); }
__device__ __forceinline__ unsigned xb_add(unsigned* p, unsigned v) { return __hip_atomic_fetch_add(p, v, __ATOMIC_RELAXED, __HIP_MEMORY_SCOPE_AGENT); }
__device__ __forceinline__ unsigned xb_xcc_id() { return (unsigned)__builtin_amdgcn_s_getreg((3 << 11) | 20) & 0xFu; }
#define XB_SPIN(cond, bar) do { unsigned _sp = 0; while (cond) { __builtin_amdgcn_s_sleep(1); \
    if ((++_sp & 255u) == 0u) { if (xb_ld(&(bar)[XB_TMO])) break; if (_sp > XB_SPIN_CAP) { atomicAdd(&(bar)[XB_TMO], 1u); break; } } } } while (0)

struct XcdBarrier {
    unsigned* bar; unsigned x;
    volatile LAS unsigned* st;
};

__device__ __forceinline__ XcdBarrier xcd_barrier_post(unsigned* bar, volatile LAS unsigned* st, int wave_s) {
    XcdBarrier b; b.bar = bar; b.x = xb_xcc_id(); b.st = st;
    if (hw_tid(wave_s) == 0) (void)xb_add(&bar[XB_XCNT(b.x)], 1u);
    return b;
}
__device__ __forceinline__ void xcd_barrier_complete(unsigned* bar, unsigned x, unsigned& nloc, unsigned& nx) {
    const unsigned G = gridDim.x * gridDim.y * gridDim.z;
    unsigned sum, cnt, mine, sp = 0u;
    for (;;) {
        sum = 0u; cnt = 0u; mine = 0u;
#pragma unroll
        for (unsigned j = 0; j < 16; ++j) { const unsigned c = xb_ld(&bar[XB_XCNT(j)]); sum += c; cnt += (c > 0u) ? 1u : 0u; mine = (j == x) ? c : mine; }
        if (sum == G) break;
        __builtin_amdgcn_s_sleep(1);
        if ((++sp & 255u) == 0u) { if (xb_ld(&bar[XB_TMO])) break; if (sp > XB_SPIN_CAP) { atomicAdd(&bar[XB_TMO], 1u); break; } }
    }
    nloc = mine > 0u ? mine : 1u; nx = cnt > 0u ? cnt : 1u;
}

__device__ __forceinline__ void xcd_barrier(const XcdBarrier& b, int wave_s) {
    asm volatile("s_waitcnt vmcnt(0)" ::: "memory");
    __syncthreads();
    if (hw_tid(wave_s) == 0) {
        unsigned* bar = b.bar;
        __builtin_amdgcn_s_waitcnt(0);
        unsigned nloc = b.st[0], nx = b.st[1];
        if (nloc == 0u) { xcd_barrier_complete(bar, b.x, nloc, nx); b.st[0] = nloc; b.st[1] = nx; }
        const unsigned old = xb_add(&bar[XB_XSUB(b.x)], 1u);
        const unsigned gen = old / nloc;
        if (old + 1u == (gen + 1u) * nloc) {
            __builtin_amdgcn_fence(__ATOMIC_RELEASE, "agent");
            asm volatile("s_waitcnt vmcnt(0)" ::: "memory");
            const unsigned og = xb_add(&bar[XB_TOP], 1u);
            const unsigned tg = og / nx;
            if (og + 1u == (tg + 1u) * nx) xb_add(&bar[XB_TOPGEN], 1u);
            else XB_SPIN(xb_ld(&bar[XB_TOPGEN]) == tg, bar);
            __builtin_amdgcn_fence(__ATOMIC_ACQUIRE, "agent");
            xb_add(&bar[XB_XGEN(b.x)], 1u);
            asm volatile("s_waitcnt vmcnt(0)" ::: "memory");
        } else {
            XB_SPIN(xb_ld(&bar[XB_XGEN(b.x)]) == gen, bar);
            __builtin_amdgcn_fence(__ATOMIC_ACQUIRE, "agent");
            asm volatile("s_waitcnt vmcnt(0)" ::: "memory");
        }
    }
    __syncthreads();
}


constexpr int NWAVES = 8, NTHREADS = 512;
constexpr int LDS_BYTES = 147456;
constexpr int PH_PRO = 0, PH_L0 = 1, PH_PER_LAYER = 9, PH_FIN = PH_L0 + DEPTH * PH_PER_LAYER, PH_COUNT = PH_FIN + 1;
struct Params { const float* in[20]; float* out; unsigned char* ws; int ph_lo, ph_hi; };

__device__ __forceinline__ float wave_sum(float v) {
    v += swz_xor<1>(v); v += swz_xor<2>(v); v += swz_xor<4>(v); v += swz_xor<8>(v); v += swz_xor<16>(v);
    { auto rr = __builtin_amdgcn_permlane32_swap(__float_as_uint(v), __float_as_uint(v), false, false); v = __uint_as_float(rr[0]) + __uint_as_float(rr[1]); }
    return v;
}
__device__ __forceinline__ int run_src(int kind, int n0, int s) {
    if (kind == 1) return n0 < GIN ? n0 + 16 * s : -1;
    if (kind == 2) { if (n0 >= SQ + SKVD) return n0 + 16 * s; const int hs = n0 >> 6, half = (n0 >> 5) & 1; return hs * 64 + 16 * half + 32 * s; }
    if (kind == 3) { const int q = n0 >> 5; return s ? FH + 16 * q : 16 * q; }
    return n0 + 16 * s;
}
__device__ __forceinline__ int run_pos(int kind, int n0, int s, int i) {
    if (kind == 2 && n0 < SQ + SKVD) return 2 * i + s;
    if (kind == 3) return 8 * (i >> 2) + 4 * s + (i & 3);
    return 16 * s + i;
}
__device__ __forceinline__ void transpose_item(const float* W, int K, int Nsrc, int Nnew, int kind, bf16* WT, LAS float* scr, int item, int lane) {
    const int nblk = Nnew / 32, kb = item / nblk, nb = item % nblk, k0 = 64 * kb, n0 = 32 * nb;
    const int s = (lane >> 2) & 1, f = lane & 3, kr = lane >> 3; const int sc = run_src(kind, n0, s);
    f32x4 v[8];
    UNR for (int it = 0; it < 8; ++it) v[it] = sc >= 0 ? *(const f32x4*)(W + (size_t)(k0 + kr + 8 * it) * Nsrc + sc + 4 * f) : (f32x4){0.f, 0.f, 0.f, 0.f};
    UNR for (int it = 0; it < 8; ++it) UNR for (int e = 0; e < 4; ++e) scr[(kr + 8 * it) * 33 + run_pos(kind, n0, s, 4 * f + e)] = v[it][e];
    asm volatile("s_waitcnt lgkmcnt(0)" ::: "memory");
    const int c = lane & 7;
    UNR for (int j = 0; j < 4; ++j) { const int n = (lane >> 3) + 8 * j; const LAS float* sp = scr + (8 * c) * 33 + n;
        u32x4 o; o.x = pk2(sp[0 * 33], sp[1 * 33]); o.y = pk2(sp[2 * 33], sp[3 * 33]); o.z = pk2(sp[4 * 33], sp[5 * 33]); o.w = pk2(sp[6 * 33], sp[7 * 33]);
        *(u32x4*)(WT + (size_t)(n0 + n) * K + k0 + 8 * c) = o; }
    asm volatile("s_waitcnt lgkmcnt(0)" ::: "memory");
}
__device__ __forceinline__ void prologue_phase(const Params& p, LAS unsigned char* lds, int tid, int lane, int wave, int G) {
    unsigned char* ws = p.ws;
    {
        LAS float* scr = (LAS float*)(lds + wave * 16384);
        const int gw = blockIdx.x * NWAVES + wave, NGW = G * NWAVES;
        constexpr int I_GIN = (D / 64) * (GINP / 32), I_GO = (GDV / 64) * (D / 32), I_SQKV = (D / 64) * (SQKV / 32), I_SO = (SQ / 64) * (D / 32), I_FIN = (D / 64) * (2 * FH / 32), I_FOUT = (FH / 64) * (D / 32);
        constexpr int NITEMS = 2 * (I_GIN + I_GO + I_SQKV + I_SO) + 4 * (I_FIN + I_FOUT);
        for (int it = gw; it < NITEMS; it += NGW) {
            int r = it;
            if (r < 2 * I_GIN) { const int j = r / I_GIN; transpose_item(p.in[8] + (size_t)j * D * GIN, D, GIN, GINP, 1, (bf16*)(ws + WS_WGIN + j * SZ_WGIN), scr, r % I_GIN, lane); continue; } r -= 2 * I_GIN;
            if (r < 2 * I_GO) { const int j = r / I_GO; transpose_item(p.in[11] + (size_t)j * GDV * D, GDV, D, D, 0, (bf16*)(ws + WS_WGO + j * SZ_WGO), scr, r % I_GO, lane); continue; } r -= 2 * I_GO;
            if (r < 2 * I_SQKV) { const int j = r / I_SQKV; transpose_item(p.in[13] + (size_t)j * D * SQKV, D, SQKV, SQKV, 2, (bf16*)(ws + WS_WSQKV + j * SZ_WSQKV), scr, r % I_SQKV, lane); continue; } r -= 2 * I_SQKV;
            if (r < 2 * I_SO) { const int j = r / I_SO; transpose_item(p.in[15] + (size_t)j * SQ * D, SQ, D, D, 0, (bf16*)(ws + WS_WSO + j * SZ_WSO), scr, r % I_SO, lane); continue; } r -= 2 * I_SO;
            if (r < 4 * I_FIN) { const int j = r / I_FIN; transpose_item(p.in[17] + (size_t)j * D * 2 * FH, D, 2 * FH, 2 * FH, 3, (bf16*)(ws + WS_WFIN + j * SZ_WFIN), scr, r % I_FIN, lane); continue; } r -= 4 * I_FIN;
            { const int j = r / I_FOUT; transpose_item(p.in[18] + (size_t)j * FH * D, FH, D, D, 0, (bf16*)(ws + WS_WFOUT + j * SZ_WFOUT), scr, r % I_FOUT, lane); }
        }
    }
    { float* rope = (float*)(ws + WS_ROPE);
      for (int idx = blockIdx.x * NTHREADS + tid; idx < SEQ * 32; idx += G * NTHREADS) { const int pp = idx & 31, t = idx >> 5;
          const float pos = (pp < 16) ? (float)(t / GRID_W) : (float)(t % GRID_W); const float inv = powf(10000.f, -(float)(pp & 15) / 16.f);
          float sn, cs; sincosf(pos * inv, &sn, &cs); rope[2 * idx] = cs; rope[2 * idx + 1] = sn; } }
    {
        __syncthreads();
        LAS float* sv = (LAS float*)lds;
        LAS float* red = (LAS float*)(lds + 3 * 1024 * 4);
        for (int i = tid; i < D; i += NTHREADS) { sv[i] = siluf(p.in[1][i]); sv[D + i] = siluf(p.in[1][D + i]); sv[2 * D + i] = siluf(p.in[3][i]); }
        __syncthreads();
        float* mod = (float*)(ws + WS_MOD);
        const int cg4 = tid & 7, kg = tid >> 3;
        for (int it = blockIdx.x; it < DEPTH * (6 * D / 32); it += G) {
            const int l = it / (6 * D / 32), e0 = (it % (6 * D / 32)) * 32;
            const float* w = p.in[4] + (size_t)l * D * 6 * D + (size_t)(kg * 16) * 6 * D + e0 + 4 * cg4;
            f32x4 wv[16];
            UNR for (int k = 0; k < 16; ++k) wv[k] = *(const f32x4*)(w + (size_t)k * 6 * D);
            f32x4 a0 = {0.f, 0.f, 0.f, 0.f}, a1 = a0, a2 = a0;
            UNR for (int k = 0; k < 16; ++k) { const int kk = kg * 16 + k; a0 += wv[k] * sv[kk]; a1 += wv[k] * sv[D + kk]; a2 += wv[k] * sv[2 * D + kk]; }
            UNR for (int e = 0; e < 4; ++e) { red[(kg * 32 + 4 * cg4 + e) * 3 + 0] = a0[e]; red[(kg * 32 + 4 * cg4 + e) * 3 + 1] = a1[e]; red[(kg * 32 + 4 * cg4 + e) * 3 + 2] = a2[e]; }
            __syncthreads();
            if (tid < 96) { const int v = tid >> 5, cl = tid & 31; float s = p.in[5][l * 6 * D + e0 + cl];
#pragma unroll 8
                for (int g = 0; g < 64; ++g) s += red[(g * 32 + cl) * 3 + v];
                mod[((size_t)l * 3 + v) * 6 * D + e0 + cl] = s; }
            __syncthreads();
        }
    }
}
__device__ __forceinline__ void norm_phase(const float* src_lat, const float* src_ctx, const float* w, const float* modl, int sh_off, bf16* XNp, int M, int gw, int NGW, int lane, bf16* Xcopy  , const float* slab, int nslab) {
    int curvec = -1; f32x4 gg[4], sh[4];
    for (int r = gw; r < M; r += NGW) {
        const int vec = rowvec(r);
        if (vec != curvec) { curvec = vec; const float* m = modl + (size_t)vec * 6 * D + sh_off;
            UNR for (int j = 0; j < 4; ++j) { const int c = lane * 4 + 256 * j; const f32x4 wv = *(const f32x4*)(w + c), sc = *(const f32x4*)(m + D + c); gg[j] = wv * (sc + 1.f); sh[j] = *(const f32x4*)(m + c); } }
        f32x4 v[4]; float s = 0.f;
        if (src_lat) { const f32x4* x = (const f32x4*)(r < MX ? src_lat + (size_t)r * D : src_ctx + (size_t)(r - MX) * D) + lane; UNR for (int j = 0; j < 4; ++j) v[j] = x[64 * j]; }
        else { const u32x2* x = (const u32x2*)(Xcopy + (size_t)r * D) + lane; UNR for (int j = 0; j < 4; ++j) { const u32x2 w = x[64 * j]; v[j] = (f32x4){__uint_as_float(w.x << 16), __uint_as_float(w.x & 0xffff0000u), __uint_as_float(w.y << 16), __uint_as_float(w.y & 0xffff0000u)}; } }
        UNR for (int j = 0; j < 4; ++j) s += (v[j][0] * v[j][0] + v[j][1] * v[j][1]) + (v[j][2] * v[j][2] + v[j][3] * v[j][3]);
        if (Xcopy && r >= MX) {
            for (int ks = 0; ks < nslab; ++ks) { const f32x4* sp = (const f32x4*)(slab + ((size_t)ks * MC + (r - MX)) * D) + lane; UNR for (int j = 0; j < 4; ++j) v[j] += sp[64 * j]; }
            s = 0.f;
            UNR for (int j = 0; j < 4; ++j) { u32x2 o; o.x = pk2(v[j][0], v[j][1]); o.y = pk2(v[j][2], v[j][3]); *((u32x2*)(Xcopy + (size_t)r * D) + lane + 64 * j) = o; s += (v[j][0] * v[j][0] + v[j][1] * v[j][1]) + (v[j][2] * v[j][2] + v[j][3] * v[j][3]); } }
        const float rs = rsqrtf(wave_sum(s) * (1.f / D) + EPS);
        UNR for (int j = 0; j < 4; ++j) { const f32x4 y = v[j] * rs * gg[j] + sh[j]; u32x2 o; o.x = pk2(y[0], y[1]); o.y = pk2(y[2], y[3]); *(u32x2*)(XNp + (size_t)r * D + lane * 4 + 256 * j) = o; }
    }
}
__device__ __forceinline__ void final_norm_phase(const bf16* X, const float* w, float* out, int gw, int NGW, int lane) {
    f32x4 wv[4];
    UNR for (int j = 0; j < 4; ++j) wv[j] = *(const f32x4*)(w + lane * 4 + 256 * j);
    for (int r = gw; r < MX; r += NGW) {
        const u32x2* x = (const u32x2*)(X + (size_t)r * D) + lane; f32x4 v[4]; float s = 0.f;
        UNR for (int j = 0; j < 4; ++j) { const u32x2 w2 = x[64 * j]; v[j] = (f32x4){__uint_as_float(w2.x << 16), __uint_as_float(w2.x & 0xffff0000u), __uint_as_float(w2.y << 16), __uint_as_float(w2.y & 0xffff0000u)}; s += (v[j][0] * v[j][0] + v[j][1] * v[j][1]) + (v[j][2] * v[j][2] + v[j][3] * v[j][3]); }
        const float rs = rsqrtf(wave_sum(s) * (1.f / D) + EPS);
        UNR for (int j = 0; j < 4; ++j) *((f32x4*)(out + (size_t)r * D) + lane + 64 * j) = v[j] * rs * wv[j];
    }
}

__global__ void __launch_bounds__(NTHREADS, 2) mega(Params p) {
    extern __shared__ __attribute__((aligned(16))) unsigned char lds_raw[];
    LAS unsigned char* lds = (LAS unsigned char*)lds_raw;
    const int G = gridDim.x;
    unsigned char* ws = p.ws;
    bf16* X = (bf16*)(ws + WS_X); bf16* XNp = (bf16*)(ws + WS_XN); const float* mod = (const float*)(ws + WS_MOD);
    volatile LAS unsigned* MISC = (volatile LAS unsigned*)(lds + LDS_BYTES - 64);
    const int wave_s = __builtin_amdgcn_readfirstlane((int)threadIdx.x >> 6);
    if (hw_tid(wave_s) < 16) MISC[hw_tid(wave_s)] = 0u;
    __syncthreads();
    XcdBarrier bar = xcd_barrier_post((unsigned*)(ws + WS_CTL), MISC + 8, wave_s);
    for (int ph = p.ph_lo; ph < p.ph_hi; ++ph) {
        int tid = hw_tid(wave_s); asm volatile("" : "+v"(tid));
        const int lane = tid & 63, wave = __builtin_amdgcn_readfirstlane(tid >> 6);
        const int gw = blockIdx.x * NWAVES + wave, NGW = G * NWAVES;
        if (ph == PH_PRO) { prologue_phase(p, lds, tid, lane, wave, G); }
        else if (ph == PH_FIN) { final_norm_phase(X, p.in[19], p.out, gw, NGW, lane); }
        else {
            const int l = (ph - PH_L0) / PH_PER_LAYER, s = (ph - PH_L0) % PH_PER_LAYER, j = l >> 1; const bool gla = (l & 1) == 0, last = (l == DEPTH - 1);
            const float* modl = mod + (size_t)l * 3 * 6 * D;
            const float* src_lat = l == 0 ? p.in[0] : nullptr; const float* src_ctx = l == 0 ? p.in[2] : nullptr;
            const int Mrows = last ? MX : MT;
            if (s == 0) { norm_phase(src_lat, src_ctx, p.in[6] + l * D, modl, 0, XNp, MT, gw, NGW, lane, X, p.out, l == 0 ? 0 : 11); }
            else if (s == 1) {
                if (gla) { pg8::Gemm g{XNp, (const bf16*)(ws + WS_WGIN + j * SZ_WGIN), MT, GINP, D, D}; pg8::StaticOrder S; S.init(MT, GINP, G, (int)blockIdx.x);
                    EpiGlaIn E{(bf16*)(ws + WS_QKVR), (float*)(ws + WS_GF)};
                    pg8::gemm_phase<EpiGlaIn, pg8::StaticOrder, true, true>(lds, g, S, E, wave_s); }
                else { pg8::Gemm g{XNp, (const bf16*)(ws + WS_WSQKV + j * SZ_WSQKV), MT, SQKV, D, D}; pg8::StaticOrder S; S.init(MT, SQKV, G, (int)blockIdx.x);
                    EpiSwaQkv E{(bf16*)(ws + WS_SQ), (bf16*)(ws + WS_SK), (bf16*)(ws + WS_SV), p.in[14] + j * SQKV, (const float*)(ws + WS_ROPE)};
                    pg8::gemm_phase<EpiSwaQkv, pg8::StaticOrder, true, true>(lds, g, S, E, wave_s); }
            }
            else if (s >= 2 && s <= 4) {
                if (gla) {
                    bf16* scr = (bf16*)p.out;
                    const GlaBufs GB{(const bf16*)(ws + WS_QKVR), (const float*)(ws + WS_GF), scr, scr + (size_t)MT * 512, scr + (size_t)2 * MT * 512, (bf16*)(ws + WS_KIB), (float*)(ws + WS_DEC), (bf16*)(ws + WS_LS), (float*)(ws + WS_DSEG), (unsigned*)(ws + WS_STASH)};
                    if (s == 2) gla_g1_phase(GB, p.in[9] + (size_t)j * 2 * 16 * 512, p.in[10] + (size_t)j * 2 * 512, lds, tid);
                    else if (s == 3) gla_g1c_phase(GB.LS, GB.DSEG, tid);
                    else gla_g2_phase(GB, p.in[12] + j * GHV, XNp, lds, tid);
                } else if (s == 2) swa_phase((const bf16*)(ws + WS_SQ), (const bf16*)(ws + WS_SK), (const bf16*)(ws + WS_SV), p.in[16] + j * SH, XNp, !last, lds, tid);
                else continue;
            }
            else if (s == 5) {
                const bf16* Wt = (const bf16*)(gla ? ws + WS_WGO + j * SZ_WGO : ws + WS_WSO + j * SZ_WSO);
                { pg8::Gemm g{XNp, Wt, MX, D, D, D}; pg8::StaticOrder S; S.init(MX, D, G, (int)blockIdx.x);
                  EpiResid E{src_lat, X, modl + 2 * D};
                  pg8::gemm_phase<EpiResid, pg8::StaticOrder, true, true>(lds, g, S, E, wave_s); }
                if (!last) { int ksl = 256; asm volatile("" : "+s"(ksl));
                  pg8::Gemm g{XNp, Wt, MT, D, ksl, D}; pg8::SplitOrder S{4, 512, (int)blockIdx.x};
                  EpiSlab E{p.out, modl + 2 * D, 512};
                  pg8::gemm_phase<EpiSlab, pg8::SplitOrder, true, true>(lds, g, S, E, wave_s); }
            }
            else if (s == 6) { norm_phase(nullptr, nullptr, p.in[7] + l * D, modl, 3 * D, XNp, Mrows, gw, NGW, lane, X, p.out, 4); }
            else if (s == 7) {
                pg8::Gemm g{XNp, (const bf16*)(ws + WS_WFIN + l * SZ_WFIN), Mrows, 2 * FH, D, D}; pg8::StaticOrder S; S.init(Mrows, 2 * FH, G, (int)blockIdx.x);
                EpiSwiglu E{(bf16*)(ws + WS_HFF)};
                pg8::gemm_phase<EpiSwiglu, pg8::StaticOrder, true, true>(lds, g, S, E, wave_s);
            }
            else if (s == 8) {
                const bf16* Wt = (const bf16*)(ws + WS_WFOUT + l * SZ_WFOUT);
                { pg8::Gemm g{(const bf16*)(ws + WS_HFF), Wt, MX, D, FH, FH}; pg8::StaticOrder S; S.init(MX, D, G, (int)blockIdx.x);
                  EpiResid E{nullptr, X, modl + 5 * D};
                  pg8::gemm_phase<EpiResid, pg8::StaticOrder, true, true>(lds, g, S, E, wave_s); }
                if (!last) { int ksl = 256; asm volatile("" : "+s"(ksl));
                  pg8::Gemm g{(const bf16*)(ws + WS_HFF), Wt, MT, D, ksl, FH}; pg8::SplitOrder S{11, 512, (int)blockIdx.x};
                  EpiSlab E{p.out, modl + 5 * D, 512};
                  pg8::gemm_phase<EpiSlab, pg8::SplitOrder, true, true>(lds, g, S, E, wave_s); }
            }
        }
        if (ph + 1 < p.ph_hi) xcd_barrier(bar, wave_s);
    }
}

extern "C" void kernel_launch(void* const* d_in, const int* in_sizes, int n_in, void* d_out, int out_size, void* d_ws, size_t ws_size, hipStream_t stream) {
    static int grid = 0;
    if (grid == 0) {
        if (n_in != 20 || ws_size < WS_END || out_size != MX * D) { fprintf(stderr, "kernel_launch: unexpected problem (n_in %d, ws %zu, out %d)\n", n_in, ws_size, out_size); grid = -1; return; }
        int dev = 0, cus = 0, per_cu = 0;
        if (hipGetDevice(&dev) != hipSuccess || hipDeviceGetAttribute(&cus, hipDeviceAttributeMultiprocessorCount, dev) != hipSuccess) { grid = -1; return; }
        if (hipFuncSetAttribute((const void*)mega, hipFuncAttributeMaxDynamicSharedMemorySize, LDS_BYTES) != hipSuccess) { fprintf(stderr, "kernel_launch: hipFuncSetAttribute failed\n"); grid = -1; return; }
        if (hipOccupancyMaxActiveBlocksPerMultiprocessor(&per_cu, (const void*)mega, NTHREADS, LDS_BYTES) != hipSuccess || per_cu < 1) { fprintf(stderr, "kernel_launch: occupancy query says %d\n", per_cu); grid = -1; return; }
        grid = cus;
    }
    if (grid < 0) return;
    if (hipMemsetAsync((char*)d_ws + WS_CTL, 0, CTL_ZERO_BYTES, stream) != hipSuccess) { fprintf(stderr, "kernel_launch: memset failed\n"); return; }
    Params p{};
    for (int i = 0; i < 20; ++i) p.in[i] = (const float*)d_in[i];
    p.out = (float*)d_out; p.ws = (unsigned char*)d_ws;
    p.ph_lo = 0; p.ph_hi = PH_COUNT;
    void* args[] = {&p};
    hipError_t e = hipLaunchCooperativeKernel((const void*)mega, dim3(grid), dim3(NTHREADS), args, LDS_BYTES, stream);
    if (e != hipSuccess) fprintf(stderr, "cooperative launch failed: %s (grid %d)\n", hipGetErrorString(e), grid);
}
```

```cpp
#include <hip/hip_runtime.h>
#include <cstdio>
#include <cstdint>
#include <hip/hip_cooperative_groups.h>
namespace cg = cooperative_groups;

constexpr int D = 1024, BATCH = 2, SEQ = 8192, DEPTH = 4, CTXL = 256, GRID_W = 64;
constexpr int MX = BATCH * SEQ, MC = BATCH * CTXL, MT = MX + MC;
constexpr float EPS = 1e-6f;
constexpr int GH = 4, GDK = 512, GDV = 1024, GHK = 128, GHV = 256, GRANK = 16, GIN = 2 * GDK + 2 * GDV + 2 * GRANK;
constexpr int GINP = 3328;
constexpr int SH = 16, SKVH = 2, SHD = 64, SQ = 1024, SKVD = 128, SQKV = 1280, SWIN = 128;
constexpr int FH = 2816;
constexpr float QSCALE_GLA = 0.08838834764831845f;
constexpr float C2 = 0.125f * 1.4426950408889634f;
constexpr float LOG2E = 1.4426950408889634f;

constexpr size_t MiB = 1u << 20;
constexpr size_t WS_CTL = 0, CTL_ZERO_BYTES = 65536;
constexpr size_t WS_MOD = 1 * MiB;
constexpr size_t WS_ROPE = 2 * MiB;
constexpr size_t WS_W = 4 * MiB;
constexpr size_t SZ_WGIN = (size_t)GINP * D * 2, SZ_WGO = (size_t)D * GDV * 2, SZ_WSQKV = (size_t)SQKV * D * 2, SZ_WSO = (size_t)D * SQ * 2, SZ_WFIN = (size_t)2 * FH * D * 2, SZ_WFOUT = (size_t)D * FH * 2;
constexpr size_t WS_WGIN = WS_W, WS_WGO = WS_WGIN + 2 * SZ_WGIN, WS_WSQKV = WS_WGO + 2 * SZ_WGO, WS_WSO = WS_WSQKV + 2 * SZ_WSQKV, WS_WFIN = WS_WSO + 2 * SZ_WSO, WS_WFOUT = WS_WFIN + 4 * SZ_WFIN;
constexpr size_t WS_WEND = WS_WFOUT + 4 * SZ_WFOUT;
constexpr size_t WS_X = 96 * MiB;
constexpr size_t WS_XN = 162 * MiB;
constexpr size_t WS_MIX = 195 * MiB;
constexpr size_t WS_END = 384 * MiB;
static_assert(WS_WEND <= WS_X, "weights fit");
constexpr size_t WS_QKVR = WS_MIX;
constexpr size_t WS_GF = WS_QKVR + (size_t)MT * 3072 * 2;
constexpr size_t WS_KIB = WS_GF + (size_t)MT * 32 * 4;
constexpr size_t WS_DEC = WS_KIB + (size_t)MT * 512 * 2;
constexpr size_t WS_LS = WS_DEC + (size_t)(MT / 64) * 4 * 2 * 128 * 4;
constexpr size_t WS_DSEG = WS_LS + (size_t)256 * 2 * 256 * 128 * 2;
constexpr size_t WS_STASH = WS_DSEG + (size_t)256 * 2 * 128 * 4;
static_assert(WS_STASH % 16 == 0 && WS_STASH + (size_t)256 * 8 * 4 * 16 * 64 * 4 <= WS_END, "gla view");
constexpr size_t WS_SQ = WS_MIX;
constexpr size_t WS_SK = WS_SQ + (size_t)MT * SQ * 2;
constexpr size_t WS_SV = WS_SK + (size_t)MT * SKVD * 2;
constexpr size_t WS_HFF = WS_MIX;
static_assert(WS_HFF + (size_t)MT * FH * 2 <= WS_END, "ffn view");

#define LAS __attribute__((address_space(3)))
typedef unsigned short bf16;
__device__ __forceinline__ float bf2f(bf16 v) { return __uint_as_float((unsigned)v << 16); }
__device__ __forceinline__ unsigned f2bf(float f) { unsigned u = __builtin_bit_cast(unsigned, f); return (u + 0x7fffu + ((u >> 16) & 1u)) >> 16; }
__device__ __forceinline__ unsigned pk2(float lo, float hi) { typedef float f2_ __attribute__((ext_vector_type(2))); typedef __bf16 b2_ __attribute__((ext_vector_type(2))); f2_ v = {lo, hi}; b2_ b = __builtin_convertvector(v, b2_); return __builtin_bit_cast(unsigned, b); }
__device__ __forceinline__ float siluf(float x) { return x * __builtin_amdgcn_rcpf(1.f + __builtin_amdgcn_exp2f(-x * 1.4426950408889634f)); }
__device__ __forceinline__ int rowvec(int r) { return r < MX ? r / SEQ : 2; }

template <int K> __device__ __forceinline__ float swz_xor(float v) { return __int_as_float(__builtin_amdgcn_ds_swizzle(__float_as_int(v), (K << 10) | 0x1f)); }
#define LDS_BARRIER() do { asm volatile("s_waitcnt lgkmcnt(0)" ::: "memory"); __builtin_amdgcn_s_barrier(); asm volatile("" ::: "memory"); } while (0)
__device__ __forceinline__ int hw_lane() { int l; asm volatile("v_mbcnt_lo_u32_b32 %0, -1, 0\n\tv_mbcnt_hi_u32_b32 %0, -1, %0" : "=v"(l)); return l; }
__device__ __forceinline__ int hw_tid(int wave_s) { return wave_s * 64 + hw_lane(); }
namespace pg8 {
#define PG8_LAS __attribute__((address_space(3)))
typedef unsigned short bf16_t;
typedef short bf16x8 __attribute__((ext_vector_type(8)));
typedef float f32x4 __attribute__((ext_vector_type(4)));
typedef unsigned u32x4 __attribute__((ext_vector_type(4)));
constexpr int BM = 256, BK = 64, HALF = 128, HTB = HALF * BK * 2  , STAGE_BYTES = 8 * HTB, NXCD = 8, WGM = 8;

__host__ __device__ __forceinline__ int lds_byte(int r, int c) { const int st = (r >> 4) * 2 + (c >> 5), rr = r & 15, cc = c & 31, ob = rr * 64 + cc * 2; return st * 1024 + (ob ^ (((ob >> 9) & 1) << 5)); }
__host__ __device__ __forceinline__ void stage_rc(int b, int& R, int& C) { const int st = b / 1024, sb = b % 1024, swz = sb ^ (((sb >> 9) & 1) << 5); R = (st >> 1) * 16 + swz / 64; C = (st & 1) * 32 + (swz % 64) / 2; }
__host__ __device__ __forceinline__ int perm32(int rho) { const int n = rho >> 4, i = rho & 15; return 8 * (i >> 2) + 4 * n + (i & 3); }

struct Unit { int pm, pn, koff; };
struct Gemm { const bf16_t* A; const bf16_t* Bt; int M, N, K, ld; };

struct StaticOrder {
    int nM, nN, nwg, G, c;
    __host__ __device__ void init(int M, int N, int G_, int c_) { nM = M / BM; nN = N / BM; nwg = nM * nN; G = G_; c = c_; }
    __host__ __device__ bool next(int i, Unit& u) const {
        const long L = (long)i * G + c; if (L >= nwg) return false;
        int wgid = (int)L; { const int q = nwg / NXCD, r = nwg % NXCD, xcd = wgid % NXCD, off = wgid / NXCD; wgid = (xcd < r ? xcd * (q + 1) : r * (q + 1) + (xcd - r) * q) + off; }
        const int nig = WGM * nN, gid = wgid / nig, fm = gid * WGM, gsz = (nM - fm) < WGM ? (nM - fm) : WGM;
        u.pm = fm + ((wgid % nig) % gsz); u.pn = (wgid % nig) / gsz; u.koff = 0; return true;
    }
    __device__ __forceinline__ void a_ready(const Unit&) const {}
    __device__ __forceinline__ void done(const Unit&) const {}
};

struct SplitOrder {
    int S, kbytes, c;
    __device__ bool next(int i, Unit& u) const { if (i > 0 || c >= 8 * S) return false; const int t = c / S; u.pm = 64 + (t >> 2); u.pn = t & 3; u.koff = (c % S) * kbytes; return true; }
    __device__ __forceinline__ void a_ready(const Unit&) const {}
    __device__ __forceinline__ void done(const Unit&) const {}
};
__device__ __forceinline__ unsigned cvt_pk_bf16(float lo, float hi) { typedef float f2_ __attribute__((ext_vector_type(2))); typedef __bf16 b2_ __attribute__((ext_vector_type(2))); f2_ v = {lo, hi}; b2_ b = __builtin_convertvector(v, b2_); return __builtin_bit_cast(unsigned, b); }
typedef float f32x2 __attribute__((ext_vector_type(2)));
template <class Epi, class Sched, bool ALIGN_EPI = false, bool SP2 = false>
__device__ __forceinline__ void gemm_phase(PG8_LAS unsigned char* lds, const Gemm g, const Sched& S, const Epi& E, int wave_s) {
    int tid = hw_tid(wave_s); asm volatile("" : "+v"(tid));
    const int wid = __builtin_amdgcn_readfirstlane(tid >> 6), lane = tid & 63, wr = wid >> 2, wc = wid & 3, fr = lane & 15, fq = lane >> 4;
    const int K = g.ld, nt = g.K / BK;
    unsigned voffA[2], voffB[2];
#pragma unroll
    for (int i = 0; i < 2; ++i) { int R, C; stage_rc(tid * 16 + i * 8192, R, C); const int Rb = Epi::PERM ? ((R & ~31) + perm32(R & 31)) : R;
        voffA[i] = (unsigned)(R * K + C) * 2u; voffB[i] = (unsigned)(Rb * K + C) * 2u; }
    const size_t kstep = (size_t)(BK * 2);
    const size_t hstep = (size_t)HALF * K * 2;
    const size_t tstep = 2 * hstep;
    const unsigned ldsw = (unsigned)wid * 1024u;
    const int aoff = lds_byte(wr * 64 + fr, fq * 8), boff = lds_byte(wc * 32 + fr, fq * 8);
#define PG8_SA(b, h) (((b) * 2 + (h)) * HTB)
#define PG8_SB(b, h) ((4 + (b) * 2 + (h)) * HTB)
#define PG8_STAGE(bufoff, gbase, voff) do { _Pragma("unroll") for (int _i = 0; _i < 2; ++_i) \
        __builtin_amdgcn_global_load_lds((const unsigned*)((const char*)(gbase) + (voff)[_i]), (PG8_LAS unsigned*)(lds + (bufoff) + ldsw + _i * 8192), 16, 0, 0); } while (0)
#define PG8_LDA(dst, b, h) do { _Pragma("unroll") for (int m = 0; m < 4; ++m) _Pragma("unroll") for (int k = 0; k < 2; ++k) dst[m][k] = *(const PG8_LAS bf16x8*)(lds + PG8_SA(b, h) + aoff + m * 2048 + k * 1024); } while (0)
#define PG8_LDB(dst, b, h) do { _Pragma("unroll") for (int n = 0; n < 2; ++n) _Pragma("unroll") for (int k = 0; k < 2; ++k) dst[n][k] = *(const PG8_LAS bf16x8*)(lds + PG8_SB(b, h) + boff + n * 2048 + k * 1024); } while (0)
#define PG8_MMA(ai, bj, At, Bt) do { __builtin_amdgcn_s_setprio(1); _Pragma("unroll") for (int m = 0; m < 4; ++m) _Pragma("unroll") for (int n = 0; n < 2; ++n) _Pragma("unroll") for (int k = 0; k < 2; ++k) \
        acc[ai][bj][m][n] = __builtin_amdgcn_mfma_f32_16x16x32_bf16(Bt[n][k], At[m][k], acc[ai][bj][m][n], 0, 0, 0); __builtin_amdgcn_s_setprio(0); } while (0)
#define PG8_WAIT_V(n) asm volatile("s_waitcnt vmcnt(" #n ")" ::: "memory")
#define PG8_WAIT_L(n) asm volatile("s_waitcnt lgkmcnt(" #n ")" ::: "memory")
#define PG8_BAR __builtin_amdgcn_s_barrier()
#define PG8_SCHED __builtin_amdgcn_sched_barrier(0)
    Unit cur, nxt; int ui = 0;
    if (!S.next(0, cur)) return;
    f32x4 acc[2][2][4][2];
#pragma unroll
    for (int a = 0; a < 2; ++a)
#pragma unroll
        for (int b = 0; b < 2; ++b)
#pragma unroll
            for (int m = 0; m < 4; ++m)
#pragma unroll
                for (int n = 0; n < 2; ++n) acc[a][b][m][n] = (f32x4){0.f, 0.f, 0.f, 0.f};
    bf16x8 At[4][2], B0[2][2], B1[2][2];
    const char* cA = (const char*)g.A + (size_t)cur.pm * tstep + cur.koff; const char* cB = (const char*)g.Bt + (size_t)cur.pn * tstep + cur.koff;
    asm volatile("" : "+s"(cA), "+s"(cB));
    S.a_ready(cur);
    if constexpr (SP2) {
        PG8_STAGE(PG8_SB(0, 0), cB, voffB); PG8_STAGE(PG8_SB(0, 1), cB + hstep, voffB); PG8_STAGE(PG8_SA(0, 0), cA, voffA); PG8_STAGE(PG8_SA(0, 1), cA + hstep, voffA);
        if (wr == 1) PG8_BAR;
        PG8_WAIT_V(2); PG8_BAR;
        PG8_STAGE(PG8_SB(1, 0), cB + kstep, voffB); PG8_STAGE(PG8_SA(1, 0), cA + kstep, voffA); PG8_STAGE(PG8_SB(1, 1), cB + hstep + kstep, voffB);
        PG8_WAIT_V(6); PG8_BAR;
    } else {
        PG8_STAGE(PG8_SB(0, 0), cB, voffB); PG8_STAGE(PG8_SA(0, 0), cA, voffA); PG8_STAGE(PG8_SB(0, 1), cB + hstep, voffB); PG8_STAGE(PG8_SA(0, 1), cA + hstep, voffA);
        if (wr == 1) PG8_BAR;
        PG8_WAIT_V(4); PG8_BAR;
        PG8_STAGE(PG8_SB(1, 0), cB + kstep, voffB); PG8_STAGE(PG8_SA(1, 0), cA + kstep, voffA); PG8_STAGE(PG8_SB(1, 1), cB + hstep + kstep, voffB);
        PG8_WAIT_V(6); PG8_BAR;
    }
    for (;;) {
        const bool has_next = S.next(ui + 1, nxt);
        const char* nA = has_next ? (const char*)g.A + (size_t)nxt.pm * tstep + nxt.koff : cA; const char* nB = has_next ? (const char*)g.Bt + (size_t)nxt.pn * tstep + nxt.koff : cB;
        asm volatile("" : "+s"(nA), "+s"(nB));
        for (int t = 0; t < nt; t += 2) {
            const bool last = (t == nt - 2);
            const char* a1 = cA + (size_t)(t + 1) * kstep;
            const char* a2 = last ? nA : cA + (size_t)(t + 2) * kstep; const char* b2 = last ? nB : cB + (size_t)(t + 2) * kstep;
            const char* a3 = a2 + kstep; const char* b3 = b2 + kstep;
            if (last && has_next) S.a_ready(nxt);
            if constexpr (SP2) {
            PG8_LDB(B0, 0, 0); PG8_LDB(B1, 0, 1); PG8_SCHED; PG8_LDA(At, 0, 0); PG8_STAGE(PG8_SA(1, 1), a1 + hstep, voffA);
            PG8_WAIT_V(8); PG8_WAIT_L(0); PG8_BAR; PG8_MMA(0, 0, At, B0); PG8_MMA(0, 1, At, B1); PG8_BAR; PG8_SCHED;
            PG8_LDA(At, 0, 1); PG8_STAGE(PG8_SB(0, 0), b2, voffB); PG8_STAGE(PG8_SB(0, 1), b2 + hstep, voffB); PG8_STAGE(PG8_SA(0, 0), a2, voffA);
            PG8_WAIT_V(8); PG8_WAIT_L(0); PG8_BAR; PG8_MMA(1, 0, At, B0); PG8_MMA(1, 1, At, B1); PG8_BAR; PG8_SCHED;
            PG8_LDB(B0, 1, 0); PG8_LDB(B1, 1, 1); PG8_SCHED; PG8_LDA(At, 1, 0); PG8_STAGE(PG8_SA(0, 1), a2 + hstep, voffA);
            PG8_WAIT_V(8); PG8_WAIT_L(0); PG8_BAR; PG8_MMA(0, 0, At, B0); PG8_MMA(0, 1, At, B1); PG8_BAR; PG8_SCHED;
            PG8_LDA(At, 1, 1); PG8_STAGE(PG8_SB(1, 0), b3, voffB); PG8_STAGE(PG8_SB(1, 1), b3 + hstep, voffB); PG8_STAGE(PG8_SA(1, 0), a3, voffA);
            PG8_WAIT_V(8); PG8_WAIT_L(0); PG8_BAR; PG8_MMA(1, 0, At, B0); PG8_MMA(1, 1, At, B1); PG8_BAR; PG8_SCHED;
            } else {
            PG8_LDB(B0, 0, 0); PG8_SCHED; PG8_LDA(At, 0, 0); PG8_STAGE(PG8_SA(1, 1), a1 + hstep, voffA);
            PG8_WAIT_L(8); PG8_BAR; PG8_WAIT_L(0); PG8_MMA(0, 0, At, B0); PG8_BAR; PG8_SCHED;
            PG8_LDB(B1, 0, 1); PG8_STAGE(PG8_SB(0, 0), b2, voffB);
            PG8_BAR; PG8_WAIT_L(0); PG8_MMA(0, 1, At, B1); PG8_BAR;
            PG8_LDA(At, 0, 1); PG8_STAGE(PG8_SA(0, 0), a2, voffA);
            PG8_BAR; PG8_WAIT_L(0); PG8_MMA(1, 0, At, B0); PG8_BAR; PG8_SCHED;
            PG8_STAGE(PG8_SB(0, 1), b2 + hstep, voffB);
            PG8_WAIT_V(6); PG8_BAR; PG8_MMA(1, 1, At, B1); PG8_BAR;
            PG8_LDB(B0, 1, 0); PG8_SCHED; PG8_LDA(At, 1, 0); PG8_STAGE(PG8_SA(0, 1), a2 + hstep, voffA);
            PG8_WAIT_L(8); PG8_BAR; PG8_WAIT_L(0); PG8_MMA(0, 0, At, B0); PG8_BAR; PG8_SCHED;
            PG8_LDB(B1, 1, 1); PG8_STAGE(PG8_SB(1, 0), b3, voffB);
            PG8_BAR; PG8_WAIT_L(0); PG8_MMA(0, 1, At, B1); PG8_BAR;
            PG8_LDA(At, 1, 1); PG8_STAGE(PG8_SA(1, 0), a3, voffA);
            PG8_BAR; PG8_WAIT_L(0); PG8_MMA(1, 0, At, B0); PG8_BAR; PG8_SCHED;
            PG8_STAGE(PG8_SB(1, 1), b3 + hstep, voffB);
            PG8_WAIT_V(6); PG8_BAR; PG8_MMA(1, 1, At, B1); PG8_BAR;
            }
        }
        if constexpr (ALIGN_EPI) { if (wr == 0) PG8_BAR; }
        if constexpr (!Epi::AFTER_DRAIN) { E(acc, cur, wr, wc, fr, fq); S.done(cur); }
        if (!has_next) break;
#pragma unroll
        for (int a = 0; a < 2; ++a)
#pragma unroll
            for (int b = 0; b < 2; ++b)
#pragma unroll
                for (int m = 0; m < 4; ++m)
#pragma unroll
                    for (int n = 0; n < 2; ++n) acc[a][b][m][n] = (f32x4){0.f, 0.f, 0.f, 0.f};
        cur = nxt; cA = nA; cB = nB; ++ui;
        if constexpr (ALIGN_EPI) { if (wr == 1) PG8_BAR; }
    }
    PG8_WAIT_V(0);
    if constexpr (!ALIGN_EPI) { if (wr == 0) PG8_BAR; }
    PG8_BAR;
    if constexpr (Epi::AFTER_DRAIN) { E.fused(acc, cur, wr, wc, fr, fq, lds, wid, lane); S.done(cur); }
#undef PG8_SA
#undef PG8_SB
#undef PG8_STAGE
#undef PG8_LDA
#undef PG8_LDB
#undef PG8_MMA
#undef PG8_WAIT_V
#undef PG8_WAIT_L
#undef PG8_BAR
#undef PG8_SCHED
}
}
using pg8::f32x4; using pg8::u32x4; using pg8::Unit; using pg8::BM; using pg8::HALF; using pg8::cvt_pk_bf16;
typedef unsigned u32x2 __attribute__((ext_vector_type(2)));
#define UNR _Pragma("unroll")
struct EpiResid {
    static constexpr bool PERM = false, AFTER_DRAIN = false;
    const float* base_f32; bf16* Xb; const float* gate;
    __device__ __forceinline__ void operator()(const f32x4 (&acc)[2][2][4][2], const Unit& u, int wr, int wc, int fr, int fq) const {
        asm volatile("" : "+v"(fr), "+v"(fq));
        const int vec = u.pm >> 5;
        const int row0 = u.pm * BM + wr * 64 + fr, col0 = u.pn * BM + wc * 32 + 4 * fq;
        const float* gp = gate + (size_t)vec * 6 * D + col0;
        f32x4 gv[2][2];
        UNR for (int bj = 0; bj < 2; ++bj) UNR for (int n = 0; n < 2; ++n) gv[bj][n] = *(const f32x4*)(gp + bj * HALF + n * 16);
        UNR for (int ai = 0; ai < 2; ++ai) UNR for (int m = 0; m < 4; ++m) {
            const size_t off = (size_t)(row0 + ai * HALF + m * 16) * D + col0;
            UNR for (int bj = 0; bj < 2; ++bj) UNR for (int n = 0; n < 2; ++n) { f32x4 b;
                if (base_f32) b = *(const f32x4*)(base_f32 + off + bj * HALF + n * 16);
                else { const u32x2 w = *(const u32x2*)(Xb + off + bj * HALF + n * 16); b = (f32x4){__uint_as_float(w.x << 16), __uint_as_float(w.x & 0xffff0000u), __uint_as_float(w.y << 16), __uint_as_float(w.y & 0xffff0000u)}; }
                const f32x4 x = b + gv[bj][n] * acc[ai][bj][m][n]; u32x2 o; o.x = cvt_pk_bf16(x[0], x[1]); o.y = cvt_pk_bf16(x[2], x[3]); *(u32x2*)(Xb + off + bj * HALF + n * 16) = o; }
        }
    }
};
struct EpiSlab {
    static constexpr bool PERM = false, AFTER_DRAIN = false;
    float* slab; const float* gate; int kbytes;
    __device__ __forceinline__ void operator()(const f32x4 (&acc)[2][2][4][2], const Unit& u, int wr, int wc, int fr, int fq) const {
        asm volatile("" : "+v"(fr), "+v"(fq));
        const int row0 = u.pm * BM - MX + wr * 64 + fr, col0 = u.pn * BM + wc * 32 + 4 * fq;
        const float* gp = gate + (size_t)2 * 6 * D + col0; float* sp = slab + (size_t)(u.koff / kbytes) * MC * D;
        f32x4 gv[2][2];
        UNR for (int bj = 0; bj < 2; ++bj) UNR for (int n = 0; n < 2; ++n) gv[bj][n] = *(const f32x4*)(gp + bj * HALF + n * 16);
        UNR for (int ai = 0; ai < 2; ++ai) UNR for (int m = 0; m < 4; ++m) { float* xp = sp + (size_t)(row0 + ai * HALF + m * 16) * D + col0;
            UNR for (int bj = 0; bj < 2; ++bj) UNR for (int n = 0; n < 2; ++n) *(f32x4*)(xp + bj * HALF + n * 16) = gv[bj][n] * acc[ai][bj][m][n]; }
    }
};
struct EpiSwiglu {
    static constexpr bool PERM = true, AFTER_DRAIN = false;
    bf16* H;
    __device__ __forceinline__ void operator()(const f32x4 (&acc)[2][2][4][2], const Unit& u, int wr, int wc, int fr, int fq) const {
        asm volatile("" : "+v"(fr), "+v"(fq));
        const int row0 = u.pm * BM + wr * 64 + fr, hc0 = u.pn * 128 + wc * 16 + 4 * fq;
        UNR for (int ai = 0; ai < 2; ++ai) UNR for (int m = 0; m < 4; ++m) { bf16* rp = H + (size_t)(row0 + ai * HALF + m * 16) * FH + hc0;
            UNR for (int bj = 0; bj < 2; ++bj) { const f32x4 g = acc[ai][bj][m][0], uu = acc[ai][bj][m][1];
                u32x2 w; w.x = cvt_pk_bf16(siluf(g[0]) * uu[0], siluf(g[1]) * uu[1]); w.y = cvt_pk_bf16(siluf(g[2]) * uu[2], siluf(g[3]) * uu[3]);
                *(u32x2*)(rp + bj * 64) = w; } }
    }
};
struct EpiGlaIn {
    static constexpr bool PERM = true, AFTER_DRAIN = false;
    bf16* QKVR; float* GF;
    __device__ __forceinline__ void operator()(const f32x4 (&acc)[2][2][4][2], const Unit& u, int wr, int wc, int fr, int fq) const {
        asm volatile("" : "+v"(fr), "+v"(fq));
        const int row0 = u.pm * BM + wr * 64 + fr;
        if (u.pn < 12) {
            const float sc = u.pn < 2 ? QSCALE_GLA : 1.f; const int col0 = u.pn * BM + wc * 32 + 8 * fq;
            UNR for (int ai = 0; ai < 2; ++ai) UNR for (int m = 0; m < 4; ++m) { bf16* rp = QKVR + (size_t)(row0 + ai * HALF + m * 16) * 3072 + col0;
                UNR for (int bj = 0; bj < 2; ++bj) { const f32x4 v0 = acc[ai][bj][m][0] * sc, v1 = acc[ai][bj][m][1] * sc;
                    u32x4 w; w.x = cvt_pk_bf16(v0[0], v0[1]); w.y = cvt_pk_bf16(v0[2], v0[3]); w.z = cvt_pk_bf16(v1[0], v1[1]); w.w = cvt_pk_bf16(v1[2], v1[3]);
                    *(u32x4*)(rp + bj * HALF) = w; } }
        } else if (wc == 0) {
            UNR for (int ai = 0; ai < 2; ++ai) UNR for (int m = 0; m < 4; ++m) { float* gp = GF + (size_t)(row0 + ai * HALF + m * 16) * 32 + 8 * fq;
                *(f32x4*)gp = acc[ai][0][m][0]; *(f32x4*)(gp + 4) = acc[ai][0][m][1]; }
        }
    }
};
struct EpiSwaQkv {
    static constexpr bool PERM = true, AFTER_DRAIN = false;
    bf16 *Qs, *Ks, *Vs; const float* bias; const float* rope;
    __device__ __forceinline__ void operator()(const f32x4 (&acc)[2][2][4][2], const Unit& u, int wr, int wc, int fr, int fq) const {
        asm volatile("" : "+v"(fr), "+v"(fq));
        const int row0 = u.pm * BM + wr * 64 + fr; const bool lat = u.pm < MX / BM;
        UNR for (int bj = 0; bj < 2; ++bj) {
            const int c0 = u.pn * BM + bj * HALF + wc * 32 + 8 * fq;
            const bool isv = c0 >= SQ + SKVD; const bool isq = c0 < SQ;
            const int hs = c0 >> 6, p0 = (c0 & 63) >> 1;
            f32x4 b0, b1;
            if (isv) { b0 = *(const f32x4*)(bias + c0); b1 = *(const f32x4*)(bias + c0 + 4); }
            else { const f32x4 x1 = *(const f32x4*)(bias + hs * 64 + p0), x2 = *(const f32x4*)(bias + hs * 64 + 32 + p0); b0 = (f32x4){x1[0], x2[0], x1[1], x2[1]}; b1 = (f32x4){x1[2], x2[2], x1[3], x2[3]}; }
            bf16* ob = isq ? Qs + c0 : (isv ? Vs + (c0 - SQ - SKVD) : Ks + (c0 - SQ)); const int ld = isq ? SQ : SKVD; const float sc = isq ? C2 : 1.f;
            UNR for (int ai = 0; ai < 2; ++ai) UNR for (int m = 0; m < 4; ++m) { const int row = row0 + ai * HALF + m * 16;
                f32x4 v0 = acc[ai][bj][m][0] + b0, v1 = acc[ai][bj][m][1] + b1;
                if (lat && !isv) { const float* rp = rope + ((size_t)(row & (SEQ - 1)) * 32 + p0) * 2; const f32x4 r0 = *(const f32x4*)rp, r1 = *(const f32x4*)(rp + 4);
                    v0 = (f32x4){v0[0] * r0[0] - v0[1] * r0[1], v0[1] * r0[0] + v0[0] * r0[1], v0[2] * r0[2] - v0[3] * r0[3], v0[3] * r0[2] + v0[2] * r0[3]};
                    v1 = (f32x4){v1[0] * r1[0] - v1[1] * r1[1], v1[1] * r1[0] + v1[0] * r1[1], v1[2] * r1[2] - v1[3] * r1[3], v1[3] * r1[2] + v1[2] * r1[3]}; }
                v0 = v0 * sc; v1 = v1 * sc;
                u32x4 w; w.x = cvt_pk_bf16(v0[0], v0[1]); w.y = cvt_pk_bf16(v0[2], v0[3]); w.z = cvt_pk_bf16(v1[0], v1[1]); w.w = cvt_pk_bf16(v1[2], v1[3]);
                *(u32x4*)(ob + (size_t)row * ld) = w; }
        }
    }
};
typedef short bf16x8_t __attribute__((ext_vector_type(8)));
typedef short s16x4_t __attribute__((ext_vector_type(4)));
typedef float f32x16_t __attribute__((ext_vector_type(16)));
__device__ __forceinline__ s16x4_t lds_tr16(LAS const unsigned char* p) { return __builtin_bit_cast(s16x4_t, __builtin_amdgcn_ds_read_tr16_b64_v4i16((LAS s16x4_t*)p)); }
__device__ __forceinline__ float halves_max(float v) { auto rr = __builtin_amdgcn_permlane32_swap(__float_as_uint(v), __float_as_uint(v), false, false); return fmaxf(__uint_as_float(rr[0]), __uint_as_float(rr[1])); }
__device__ __forceinline__ float halves_sum(float v) { auto rr = __builtin_amdgcn_permlane32_swap(__float_as_uint(v), __float_as_uint(v), false, false); return __uint_as_float(rr[0]) + __uint_as_float(rr[1]); }
__device__ __forceinline__ unsigned cvtpk(float lo, float hi) { typedef float f2 __attribute__((ext_vector_type(2))); typedef __bf16 b2 __attribute__((ext_vector_type(2))); f2 v = {lo, hi}; b2 b = __builtin_convertvector(v, b2); return __builtin_bit_cast(unsigned, b); }
constexpr int SWA_LDS_K = 0, SWA_LDS_V = 8192;

__device__ __forceinline__ void swa_step(const bf16x8_t (&kf)[2][4], const bf16x8_t (&qf)[4], float& m, float& l, f32x16_t (&o)[2], LAS const unsigned char* vp, int mode, int qq, int hi) {
    f32x16_t sA = {}, sB = {};
    UNR for (int s = 0; s < 4; ++s) { sA = __builtin_amdgcn_mfma_f32_32x32x16_bf16(kf[0][s], qf[s], sA, 0, 0, 0); sB = __builtin_amdgcn_mfma_f32_32x32x16_bf16(kf[1][s], qf[s], sB, 0, 0, 0); }
    if (mode != 0) {
        UNR for (int r = 0; r < 16; ++r) { const int kk = (r & 3) + 8 * (r >> 2) + 4 * hi;
            const bool va = mode == 1 ? (kk >= qq) : (kk <= qq), vb = mode == 1 ? (kk + 32 >= qq) : (kk + 32 <= qq);
            sA[r] = va ? sA[r] : -1e30f; sB[r] = vb ? sB[r] : -1e30f; }
    }
    float rm = fmaxf(sA[0], sB[0]);
    UNR for (int r = 1; r < 16; ++r) rm = fmaxf(rm, fmaxf(sA[r], sB[r]));
    rm = halves_max(rm);
    if (__any(rm > m)) {
        const float mn = fmaxf(m, rm), alpha = __builtin_amdgcn_exp2f(m - mn); m = mn; l *= alpha;
        UNR for (int r = 0; r < 16; ++r) { o[0][r] *= alpha; o[1][r] *= alpha; }
    }
    float ps = 0.f;
    UNR for (int r = 0; r < 16; ++r) { sA[r] = __builtin_amdgcn_exp2f(sA[r] - m); sB[r] = __builtin_amdgcn_exp2f(sB[r] - m); ps += sA[r] + sB[r]; }
    l += ps;
    UNR for (int s = 0; s < 4; ++s) {
        const int rb = 8 * (s & 1);
        union { unsigned u[4]; bf16x8_t v; } pf;
        if (s < 2) { pf.u[0] = cvtpk(sA[rb], sA[rb + 1]); pf.u[1] = cvtpk(sA[rb + 2], sA[rb + 3]); pf.u[2] = cvtpk(sA[rb + 4], sA[rb + 5]); pf.u[3] = cvtpk(sA[rb + 6], sA[rb + 7]); }
        else       { pf.u[0] = cvtpk(sB[rb], sB[rb + 1]); pf.u[1] = cvtpk(sB[rb + 2], sB[rb + 3]); pf.u[2] = cvtpk(sB[rb + 4], sB[rb + 5]); pf.u[3] = cvtpk(sB[rb + 6], sB[rb + 7]); }
        UNR for (int dt = 0; dt < 2; ++dt) {
            const s16x4_t lo = lds_tr16(vp + dt * 4096 + s * 1024), hh = lds_tr16(vp + dt * 4096 + s * 1024 + 512);
            const bf16x8_t vf = {lo[0], lo[1], lo[2], lo[3], hh[0], hh[1], hh[2], hh[3]};
            o[dt] = __builtin_amdgcn_mfma_f32_32x32x16_bf16(vf, pf.v, o[dt], 0, 0, 0);
        }
    }
}
__device__ __forceinline__ void swa_store(const f32x16_t (&o)[2], float m, float l, float sink2, bf16* op  , int hi) {
    const float lt = halves_sum(l) + __builtin_amdgcn_exp2f(sink2 - m), inv = 1.f / lt;
    UNR for (int dt = 0; dt < 2; ++dt) UNR for (int i = 0; i < 4; ++i) { u32x2 w; w.x = cvtpk(o[dt][4 * i] * inv, o[dt][4 * i + 1] * inv); w.y = cvtpk(o[dt][4 * i + 2] * inv, o[dt][4 * i + 3] * inv);
        *(u32x2*)(op + 32 * dt + 8 * i + 4 * hi) = w; }
}
__device__ __forceinline__ void swa_phase(const bf16* Qs, const bf16* Ks, const bf16* Vs, const float* sinks, bf16* Out, bool with_ctx, LAS unsigned char* lds, int tid) {
    const int lane = tid & 63, wave = __builtin_amdgcn_readfirstlane(tid >> 6), r32 = lane & 31, hi = lane >> 5;
    const int nitems = 512 + (with_ctx ? 32 : 0);
    LAS const unsigned char* vp = lds + SWA_LDS_V + ((lane >> 4) & 1) * 32 + (lane & 3) * 8 + (4 * hi + ((lane & 15) >> 2)) * 64;
    const int skey = tid >> 3, sch = tid & 7;
    for (int item = blockIdx.x; item < nitems; item += gridDim.x) {
        int b, kvh, qrow0, nqt, kt_lo, kt_hi, tok0;
        if (item < 512) { b = item >> 8; kvh = (item >> 7) & 1; const int n2 = item & 127; nqt = 2; tok0 = 64 * n2; qrow0 = b * SEQ + tok0; kt_lo = n2 < 2 ? 2 - n2 : 0; kt_hi = n2 > 125 ? 129 - n2 : 4; }
        else { const int c = item - 512; b = c >> 4; kvh = (c >> 3) & 1; nqt = 1; tok0 = 0; qrow0 = MX + b * CTXL + 32 * (c & 7); kt_lo = 5; kt_hi = 4; }
        const int head = kvh * 8 + wave; const float sink2 = sinks[head] * LOG2E;
        bf16x8_t qf[2][4];
        UNR for (int qt = 0; qt < 2; ++qt) UNR for (int s = 0; s < 4; ++s) qf[qt][s] = *(const bf16x8_t*)(Qs + (size_t)(qrow0 + (qt < nqt ? 32 * qt : 0) + r32) * SQ + head * 64 + 16 * s + 8 * hi);
        float m[2] = {sink2, sink2}, l[2] = {0.f, 0.f}; f32x16_t o[2][2] = {};
        const int ntiles = (kt_hi - kt_lo + 1) + 4;
        auto tile_row = [&](int ti) -> int { const int kt = kt_lo + ti; return kt <= kt_hi ? b * SEQ + tok0 - 128 + 64 * kt : MX + b * CTXL + 64 * (kt - kt_hi - 1); };
        u32x4 kreg, vreg;
        { const int kr = tile_row(0) + skey; kreg = *(const u32x4*)(Ks + (size_t)kr * SKVD + kvh * 64 + 8 * sch); vreg = *(const u32x4*)(Vs + (size_t)kr * SKVD + kvh * 64 + 8 * sch); }
        for (int ti = 0; ti < ntiles; ++ti) {
            LDS_BARRIER();
            *(LAS u32x4*)(lds + SWA_LDS_K + skey * 128 + ((sch ^ (skey & 7)) * 16)) = kreg;
            *(LAS u32x4*)(lds + SWA_LDS_V + (sch >> 2) * 4096 + skey * 64 + (sch & 3) * 16) = vreg;
            LDS_BARRIER();
            if (ti + 1 < ntiles) { const int kr = tile_row(ti + 1) + skey; kreg = *(const u32x4*)(Ks + (size_t)kr * SKVD + kvh * 64 + 8 * sch); vreg = *(const u32x4*)(Vs + (size_t)kr * SKVD + kvh * 64 + 8 * sch); }
            bf16x8_t kf[2][4];
            UNR for (int mt = 0; mt < 2; ++mt) UNR for (int s = 0; s < 4; ++s) { const int row = 32 * mt + r32; kf[mt][s] = *(LAS const bf16x8_t*)(lds + SWA_LDS_K + row * 128 + (((2 * s + hi) ^ (row & 7)) * 16)); }
            const int kt = kt_lo + ti; const int mode = kt == 0 ? 1 : (kt == 4 ? 2 : 0);
            const bool band = kt <= kt_hi; const int md = band ? mode : 0;
            swa_step(kf, qf[0], m[0], l[0], o[0], vp, md, r32, hi);
            if (nqt > 1) swa_step(kf, qf[1], m[1], l[1], o[1], vp, md, 32 + r32, hi);
        }
        bf16* op = Out + (size_t)(qrow0 + r32) * SQ + head * 64;
        swa_store(o[0], m[0], l[0], sink2, op, hi);
        if (nqt > 1) swa_store(o[1], m[1], l[1], sink2, op + (size_t)32 * SQ, hi);
    }
}
constexpr int GLA_NSEG = 32, GLA_ITEMS = BATCH * GH * GLA_NSEG;
__device__ __forceinline__ int seg_rowbase(int b, int sg) { return sg == 0 ? MX + b * CTXL : b * SEQ + (sg <= 4 ? (sg - 1) * 320 : 1280 + (sg - 5) * 256); }
__device__ __forceinline__ int seg_nch(int sg) { return (sg >= 1 && sg <= 4) ? 5 : 4; }
__device__ __forceinline__ float log2sig_scaled(float a) {
    const float t = -fabsf(a) * LOG2E; return (fminf(a, 0.f) * LOG2E - __builtin_amdgcn_logf(1.f + __builtin_amdgcn_exp2f(t))) * (1.f / 16.f);
}
struct GlaBufs { const bf16* QKVR; const float* GF; bf16 *QDF, *KIF, *QDB, *KIB; float* DEC; bf16* LS; float* DSEG; unsigned* STASH; };
__device__ __forceinline__ int tr_lane_off(int lane) { return ((lane >> 4) & 1) * 32 + (lane & 3) * 8 + (4 * (lane >> 5) + ((lane & 15) >> 2)) * 64; }
__device__ __forceinline__ bf16x8_t tr_frag(LAS const unsigned char* p) { const s16x4_t lo = lds_tr16(p), hh = lds_tr16(p + 512); return (bf16x8_t){lo[0], lo[1], lo[2], lo[3], hh[0], hh[1], hh[2], hh[3]}; }

constexpr int GS = 4096 + 64;
constexpr int G1_KI = 0, G1_Q = 4 * GS, G1_V = 8 * GS, G1_GFS = 16 * GS, G1_PRE = G1_GFS + 4096, G1_TOT = G1_PRE + 32768, G1_DECL = G1_TOT + 2048;
__device__ __forceinline__ void gla_g1_phase(const GlaBufs& B, const float* wg, const float* bg, LAS unsigned char* lds, int tid) {
    const int wave = __builtin_amdgcn_readfirstlane(tid >> 6);
    for (int item = blockIdx.x; item < GLA_ITEMS; item += gridDim.x) {
        const int b = item / (GH * GLA_NSEG), h = (item / GLA_NSEG) % GH, sg = item % GLA_NSEG, rb = seg_rowbase(b, sg), nch = seg_nch(sg);
        const size_t slot = (size_t)((b * GH + h) * GLA_NSEG + sg) * 2;
        f32x16_t L[4] = {};
        u32x4 pq[2], pk[2], pv[4]; f32x4 pgf = {0.f, 0.f, 0.f, 0.f};
        float wB[8], bias, Bprev = 0.f;
        auto load_w = [&](int dr) { int tt_ = tid; asm volatile("" : "+v"(tt_)); const int ln = tt_ & 63; const float* wp = wg + (size_t)dr * 16 * 512 + h * 128 + 32 * (wave & 3) + (ln & 31) + (size_t)(ln >> 5) * 512;
            UNR for (int s2 = 0; s2 < 8; ++s2) wB[s2] = wp[(size_t)(2 * s2) * 512]; bias = bg[dr * 512 + h * 128 + (tt_ & 127)]; };
        load_w(0);
        auto issue = [&](int hs) { const int dr = hs < nch ? 0 : 1, cc = dr ? 2 * nch - 1 - hs : hs, rr = rb + 64 * cc; int tt_ = tid; asm volatile("" : "+v"(tt_));
            const char* src = (const char*)(B.QKVR + (size_t)rr * 3072 + h * 128);
            UNR for (int k = 0; k < 2; ++k) { const int q = tt_ + 512 * k, tok = q >> 4, ch = q & 15; const unsigned go = (unsigned)(tok * 3072 + 8 * ch) * 2u; pq[k] = *(const u32x4*)(src + go); pk[k] = *(const u32x4*)(src + 1024 + go); }
            UNR for (int k = 0; k < 4; ++k) { const int q = tt_ + 512 * k, tok = q >> 5, ch = q & 31; pv[k] = *(const u32x4*)(src + (1024 + h * 128) * 2 + (unsigned)(tok * 3072 + 8 * ch) * 2u); }
            if (tt_ < 256) { const int tok = tt_ >> 2, part = tt_ & 3; pgf = *(const f32x4*)(B.GF + (size_t)(rr + tok) * 32 + dr * 16 + part * 4); } };
        issue(0);
#pragma unroll 1
        for (int hs = 0; hs < 2 * nch; ++hs) {
            const int dir = hs < nch ? 0 : 1, ci = dir ? 2 * nch - 1 - hs : hs, row0 = rb + 64 * ci;
            int t_ = tid; asm volatile("" : "+v"(t_));
            const int lane = t_ & 63, hi = lane >> 5, dk = t_ & 127, tq = t_ >> 7; const int troff = tr_lane_off(lane);
            unsigned lq[2], lv[4];
            UNR for (int k = 0; k < 2; ++k) { const int q = t_ + 512 * k, tok = q >> 4, ch = q & 15; lq[k] = (unsigned)((ch >> 2) * GS + tok * 64 + (ch & 3) * 16); }
            UNR for (int k = 0; k < 4; ++k) { const int q = t_ + 512 * k, tok = q >> 5, ch = q & 31; lv[k] = (unsigned)((ch >> 2) * GS + tok * 64 + (ch & 3) * 16); }
            const unsigned ltile = (unsigned)((dk >> 5) * GS + (16 * tq) * 64 + (dk & 31) * 2);
            LDS_BARRIER();
            UNR for (int k = 0; k < 2; ++k) { *(LAS u32x4*)(lds + G1_Q + lq[k]) = pq[k]; *(LAS u32x4*)(lds + G1_KI + lq[k]) = pk[k]; }
            UNR for (int k = 0; k < 4; ++k) *(LAS u32x4*)(lds + G1_V + lv[k]) = pv[k];
            if (t_ < 256) *(LAS f32x4*)(lds + G1_GFS + (t_ >> 2) * 64 + (t_ & 3) * 16) = pgf;
            LDS_BARRIER();
            if (hs == nch) load_w(1);
            if (hs + 1 < 2 * nch) issue(hs + 1);
            { f32x16_t c = {}; const LAS float* gp = (const LAS float*)(lds + G1_GFS) + (32 * (wave >> 2) + (lane & 31)) * 16 + hi;
              UNR for (int s2 = 0; s2 < 8; ++s2) c = __builtin_amdgcn_mfma_f32_32x32x2f32(gp[2 * s2], wB[s2], c, 0, 0, 0);
              LAS float* pw = (LAS float*)(lds + G1_PRE) + (32 * (wave >> 2) + 4 * hi) * 128 + 32 * (wave & 3) + (lane & 31);
              UNR for (int r = 0; r < 16; ++r) pw[((r & 3) + 8 * (r >> 2)) * 128] = c[r]; }
            LDS_BARRIER();
            float pp[16];
            UNR for (int tt = 0; tt < 16; ++tt) pp[tt] = *((const LAS float*)(lds + G1_PRE) + (16 * tq + tt) * 128 + dk) + bias;
            float run = 0.f;
            if (dir == 0) { UNR for (int tt = 0; tt < 16; ++tt) { run += log2sig_scaled(pp[tt]); pp[tt] = run; } }
            else { UNR for (int tt = 15; tt >= 0; --tt) { run += log2sig_scaled(pp[tt]); pp[tt] = run; } }
            *(LAS float*)(lds + G1_TOT + (tq * 128 + dk) * 4) = run;
            LDS_BARRIER();
            float off = 0.f, tot = 0.f;
            UNR for (int t4 = 0; t4 < 4; ++t4) { const float a = *(LAS float*)(lds + G1_TOT + (t4 * 128 + dk) * 4); tot += a; if (dir == 0 ? (t4 < tq) : (t4 > tq)) off += a; }
            { LAS unsigned char* qt = lds + G1_Q + ltile; LAS unsigned char* kt = lds + G1_KI + ltile;
              UNR for (int tt = 0; tt < 16; ++tt) { const float b2 = Bprev + off + pp[tt];
                  const float qd = bf2f(*(LAS bf16*)(qt + tt * 64)) * __builtin_amdgcn_exp2f(b2), ki = bf2f(*(LAS bf16*)(kt + tt * 64)) * __builtin_amdgcn_exp2f(-b2);
                  const unsigned pk_ = cvtpk(qd, ki);
                  *(LAS bf16*)(qt + tt * 64) = (bf16)(pk_ & 0xffffu); *(LAS bf16*)(kt + tt * 64) = (bf16)(pk_ >> 16); } }
            Bprev += tot;
            LDS_BARRIER();
            { char* oq = (char*)((dir ? B.QDB : B.QDF) + (size_t)row0 * 512 + h * 128); char* ok = (char*)((dir ? B.KIB : B.KIF) + (size_t)row0 * 512 + h * 128);
              UNR for (int k = 0; k < 2; ++k) { const int q = t_ + 512 * k, tok = q >> 4, ch = q & 15; const unsigned go = (unsigned)(tok * 512 + 8 * ch) * 2u;
                  *(u32x4*)(oq + go) = *(LAS u32x4*)(lds + G1_Q + lq[k]); *(u32x4*)(ok + go) = *(LAS u32x4*)(lds + G1_KI + lq[k]); } }
            { LAS const unsigned char* vimg = lds + G1_V + wave * GS + troff; LAS const unsigned char* kimg = lds + G1_KI + troff;
              UNR for (int s = 0; s < 4; ++s) { const bf16x8_t vf = tr_frag(vimg + s * 1024);
                  UNR for (int mt = 0; mt < 4; ++mt) { const bf16x8_t kf = tr_frag(kimg + mt * GS + s * 1024); L[mt] = __builtin_amdgcn_mfma_f32_32x32x16_bf16(kf, vf, L[mt], 0, 0, 0); } }
            }
            if (hs == nch - 1 || hs == 2 * nch - 1) {
                const float dtot = __builtin_amdgcn_exp2f(Bprev);
                if (tq == 0) { *(LAS float*)(lds + G1_DECL + dk * 4) = dtot; B.DSEG[(slot + dir) * 128 + dk] = dtot; }
                LDS_BARRIER();
                const int dv = 32 * wave + (lane & 31); bf16* lp = B.LS + ((slot + dir) * 256 + dv) * 128;
                UNR for (int mt = 0; mt < 4; ++mt) UNR for (int i4 = 0; i4 < 4; ++i4) { const f32x4 d = *(LAS const f32x4*)(lds + G1_DECL + (32 * mt + 8 * i4 + 4 * hi) * 4);
                    u32x2 w; w.x = cvtpk(L[mt][4 * i4] * d[0], L[mt][4 * i4 + 1] * d[1]); w.y = cvtpk(L[mt][4 * i4 + 2] * d[2], L[mt][4 * i4 + 3] * d[3]); *(u32x2*)(lp + 32 * mt + 8 * i4 + 4 * hi) = w;
                    L[mt][4 * i4] = 0.f; L[mt][4 * i4 + 1] = 0.f; L[mt][4 * i4 + 2] = 0.f; L[mt][4 * i4 + 3] = 0.f; }
                Bprev = 0.f; }
        }
    }
}
__device__ __forceinline__ void gla_g1c_phase(bf16* LS, const float* DSEG, int tid) {
    const int gid = blockIdx.x * 512 + tid; if (gid >= 8 * 2 * 256 * 32) return;
    const int q4 = gid & 31, dv = (gid >> 5) & 255, dir = (gid >> 13) & 1, bh = gid >> 14;
    float S[4] = {0.f, 0.f, 0.f, 0.f};
    for (int blk = 0; blk < 4; ++blk) {
        u32x2 Lr[8]; f32x4 Dr[8];
        UNR for (int k = 0; k < 8; ++k) { const int pos = blk * 8 + k; const int sg = dir == 0 ? pos : (pos == 0 ? 0 : GLA_NSEG - pos);
            const size_t slot = (size_t)(bh * GLA_NSEG + sg) * 2 + dir; Lr[k] = *(const u32x2*)(LS + (slot * 256 + dv) * 128 + 4 * q4); Dr[k] = *(const f32x4*)(DSEG + slot * 128 + 4 * q4); }
        UNR for (int k = 0; k < 8; ++k) { const int pos = blk * 8 + k; const int sg = dir == 0 ? pos : (pos == 0 ? 0 : GLA_NSEG - pos);
            const size_t slot = (size_t)(bh * GLA_NSEG + sg) * 2 + dir;
            u32x2 w; w.x = cvtpk(S[0], S[1]); w.y = cvtpk(S[2], S[3]); *(u32x2*)(LS + (slot * 256 + dv) * 128 + 4 * q4) = w;
            const float l0 = __uint_as_float(Lr[k].x << 16), l1 = __uint_as_float(Lr[k].x & 0xffff0000u), l2 = __uint_as_float(Lr[k].y << 16), l3 = __uint_as_float(Lr[k].y & 0xffff0000u);
            S[0] = Dr[k][0] * S[0] + l0; S[1] = Dr[k][1] * S[1] + l1; S[2] = Dr[k][2] * S[2] + l2; S[3] = Dr[k][3] * S[3] + l3; }
    }
}
constexpr int G2_QD = 0, G2_KI = 17408, G2_V = G2_KI + 4 * GS, G2_AM = G2_V + 8 * GS, G2_DECL = G2_AM + 8704, G2_OB = G2_DECL + 512;
__device__ __forceinline__ void gla_load_state(f32x16_t (&S)[4], const bf16* LS, size_t slot, int dv, int hi) {
    const bf16* lp = LS + (slot * 256 + dv) * 128;
    UNR for (int mt = 0; mt < 4; ++mt) UNR for (int i4 = 0; i4 < 4; ++i4) { const u32x2 w = *(const u32x2*)(lp + 32 * mt + 8 * i4 + 4 * hi);
        S[mt][4 * i4] = __uint_as_float(w.x << 16); S[mt][4 * i4 + 1] = __uint_as_float(w.x & 0xffff0000u); S[mt][4 * i4 + 2] = __uint_as_float(w.y << 16); S[mt][4 * i4 + 3] = __uint_as_float(w.y & 0xffff0000u); }
}
__device__ __forceinline__ void gla_g2_phase(const GlaBufs& B, const float* onorm, bf16* A3, LAS unsigned char* lds, int tid) {
    const int wave = __builtin_amdgcn_readfirstlane(tid >> 6);
    for (int item = blockIdx.x; item < GLA_ITEMS; item += gridDim.x) {
        const int b = item / (GH * GLA_NSEG), h = (item / GLA_NSEG) % GH, sg = item % GLA_NSEG, rb = seg_rowbase(b, sg);
        const size_t slot = (size_t)((b * GH + h) * GLA_NSEG + sg) * 2;
        f32x16_t S[4]; const int nch = seg_nch(sg);
        u32x4 pq[2], pk[2], pv[4];
        auto issue = [&](int st) { const int dr = st < nch ? 1 : 0, cc = st < nch ? nch - 1 - st : st - nch, rr = rb + 64 * cc;
            int tt_ = tid; asm volatile("" : "+v"(tt_));
            const char* qs = (const char*)((dr ? B.QDB : B.QDF) + (size_t)rr * 512 + h * 128); const char* ks = (const char*)((dr ? B.KIB : B.KIF) + (size_t)rr * 512 + h * 128);
            UNR for (int k = 0; k < 2; ++k) { const int q = tt_ + 512 * k, tok = q >> 4, ch = q & 15; const unsigned go = (unsigned)(tok * 512 + 8 * ch) * 2u; pq[k] = *(const u32x4*)(qs + go); pk[k] = *(const u32x4*)(ks + go); }
            { const char* vs = (const char*)(B.QKVR + (size_t)rr * 3072 + 1024 + h * 256);
              UNR for (int k = 0; k < 4; ++k) { const int q = tt_ + 512 * k, tok = q >> 5, ch = q & 31; pv[k] = *(const u32x4*)(vs + (unsigned)(tok * 3072 + 8 * ch) * 2u); } }
        };
        issue(0);
#pragma unroll 1
        for (int step = 0; step < 2 * nch; ++step) {
            const int dir = step < nch ? 1 : 0, ci = step < nch ? nch - 1 - step : step - nch, r0 = rb + 64 * ci;
            int t_ = tid; asm volatile("" : "+v"(t_));
            const int lane = t_ & 63, hi = lane >> 5, r32 = lane & 31, dv = 32 * wave + r32; const int troff = tr_lane_off(lane);
            unsigned lqd[2], lki[2], lv[4];
            UNR for (int k = 0; k < 2; ++k) { const int q = t_ + 512 * k, tok = q >> 4, ch = q & 15; lqd[k] = (unsigned)(tok * 272 + ch * 16); lki[k] = (unsigned)((ch >> 2) * GS + tok * 64 + (ch & 3) * 16); }
            UNR for (int k = 0; k < 4; ++k) { const int q = t_ + 512 * k, tok = q >> 5, ch = q & 31; lv[k] = (unsigned)((ch >> 2) * GS + tok * 64 + (ch & 3) * 16); }
            u32x4* stp = (u32x4*)(B.STASH + (size_t)(blockIdx.x * 8 + wave) * 4 * 16 * 64) + lane;
            if (step == 0) gla_load_state(S, B.LS, slot + 1, dv, hi);
            if (step == nch) { asm volatile("s_waitcnt vmcnt(0)" ::: "memory"); gla_load_state(S, B.LS, slot + 0, dv, hi); }
            LDS_BARRIER();
            UNR for (int k = 0; k < 2; ++k) { *(LAS u32x4*)(lds + G2_QD + lqd[k]) = pq[k]; *(LAS u32x4*)(lds + G2_KI + lki[k]) = pk[k]; }
            UNR for (int k = 0; k < 4; ++k) *(LAS u32x4*)(lds + G2_V + lv[k]) = pv[k];
            LDS_BARRIER();
            if (step + 1 < 2 * nch) issue(step + 1);
            u32x4 pst[4];
            if (dir == 0 && ci > 0) { UNR for (int q4 = 0; q4 < 4; ++q4) pst[q4] = stp[((ci - 1) * 4 + q4) * 64]; }
            u32x4 prr[4];
            if (dir == 0) { const bf16* rp0 = B.QKVR + (size_t)r0 * 3072 + 2048 + h * 256 + ((t_ >> 3) * 3072 + 32 * (t_ & 7)); UNR for (int k = 0; k < 4; ++k) prr[k] = *(const u32x4*)(rp0 + 8 * k); }
            { const int it4 = wave >> 1, l15 = lane & 15, l4 = lane >> 4; const int i = 16 * it4 + l15;
              UNR for (int jj = 0; jj < 2; ++jj) { const int jt = 2 * (wave & 1) + jj; f32x4 c = {0.f, 0.f, 0.f, 0.f};
                  const bool need = dir == 0 ? (jt <= it4) : (jt >= it4);
                  if (need) { UNR for (int s = 0; s < 4; ++s) {
                          const bf16x8_t a = *(LAS const bf16x8_t*)(lds + G2_KI + s * GS + (16 * jt + l15) * 64 + l4 * 16);
                          const bf16x8_t bq = *(LAS const bf16x8_t*)(lds + G2_QD + i * 272 + (4 * s + l4) * 16);
                          c = __builtin_amdgcn_mfma_f32_16x16x32_bf16(a, bq, c, 0, 0, 0); }
                      if (jt == it4) { UNR for (int e = 0; e < 4; ++e) { const int j = 16 * jt + 4 * l4 + e; const bool keep = dir == 0 ? (j <= i) : (j >= i); c[e] = keep ? c[e] : 0.f; } } }
                  u32x2 w; w.x = cvtpk(c[0], c[1]); w.y = cvtpk(c[2], c[3]);
                  *(LAS u32x2*)(lds + G2_AM + i * 136 + (4 * jt + l4) * 8) = w; } }
            LDS_BARRIER();
            f32x16_t o[2]; bf16x8_t vf[4];
            UNR for (int s = 0; s < 4; ++s) vf[s] = tr_frag(lds + G2_V + wave * GS + troff + s * 1024);
            UNR for (int it = 0; it < 2; ++it) { const int row = 32 * it + r32; o[it] = (f32x16_t){};
                UNR for (int s = 0; s < 4; ++s) { union { u32x2 h2[2]; bf16x8_t v; } af;
                    af.h2[0] = *(LAS const u32x2*)(lds + G2_AM + row * 136 + (4 * s + hi) * 8); af.h2[1] = *(LAS const u32x2*)(lds + G2_AM + row * 136 + (4 * s + 2 + hi) * 8);
                    o[it] = __builtin_amdgcn_mfma_f32_32x32x16_bf16(af.v, vf[s], o[it], 0, 0, 0); } }
            __builtin_amdgcn_sched_barrier(0);
            UNR for (int s8 = 0; s8 < 8; ++s8) { const int rbase = 8 * (s8 & 1); const f32x16_t& Sm = S[s8 >> 1];
                union { unsigned u[4]; bf16x8_t v; } sf; sf.u[0] = cvtpk(Sm[rbase], Sm[rbase + 1]); sf.u[1] = cvtpk(Sm[rbase + 2], Sm[rbase + 3]); sf.u[2] = cvtpk(Sm[rbase + 4], Sm[rbase + 5]); sf.u[3] = cvtpk(Sm[rbase + 6], Sm[rbase + 7]);
                UNR for (int it = 0; it < 2; ++it) { const int row = 32 * it + r32; union { u32x2 h2[2]; bf16x8_t v; } af;
                    af.h2[0] = *(LAS const u32x2*)(lds + G2_QD + row * 272 + 32 * s8 + 8 * hi); af.h2[1] = *(LAS const u32x2*)(lds + G2_QD + row * 272 + 32 * s8 + 16 + 8 * hi);
                    o[it] = __builtin_amdgcn_mfma_f32_32x32x16_bf16(af.v, sf.v, o[it], 0, 0, 0); } }
            __builtin_amdgcn_sched_barrier(0);
            UNR for (int s = 0; s < 4; ++s) { const bf16x8_t vf2 = tr_frag(lds + G2_V + wave * GS + troff + s * 1024);
                UNR for (int mt = 0; mt < 4; ++mt) { const bf16x8_t kf = tr_frag(lds + G2_KI + mt * GS + troff + s * 1024); S[mt] = __builtin_amdgcn_mfma_f32_32x32x16_bf16(kf, vf2, S[mt], 0, 0, 0); } }
            if (dir == 1) {
                if (ci == 0) { UNR for (int it = 0; it < 2; ++it) UNR for (int r = 0; r < 16; ++r) *(LAS float*)(lds + G2_OB + ((32 * it + (r & 3) + 8 * (r >> 2) + 4 * hi) * 256 + dv) * 4) = o[it][r]; }
                else { UNR for (int it = 0; it < 2; ++it) UNR for (int e4 = 0; e4 < 2; ++e4) { u32x4 w; w.x = cvtpk(o[it][8 * e4], o[it][8 * e4 + 1]); w.y = cvtpk(o[it][8 * e4 + 2], o[it][8 * e4 + 3]); w.z = cvtpk(o[it][8 * e4 + 4], o[it][8 * e4 + 5]); w.w = cvtpk(o[it][8 * e4 + 6], o[it][8 * e4 + 7]);
                    stp[((ci - 1) * 4 + it * 2 + e4) * 64] = w; } }
            } else {
                if (ci == 0) { UNR for (int it = 0; it < 2; ++it) UNR for (int r = 0; r < 16; ++r) { LAS float* ob = (LAS float*)(lds + G2_OB + ((32 * it + (r & 3) + 8 * (r >> 2) + 4 * hi) * 256 + dv) * 4); *ob = *ob + o[it][r]; } }
                else { unsigned pk[16];
                    UNR for (int q4 = 0; q4 < 4; ++q4) { const u32x4 w = pst[q4]; pk[4 * q4] = w.x; pk[4 * q4 + 1] = w.y; pk[4 * q4 + 2] = w.z; pk[4 * q4 + 3] = w.w; }
                    UNR for (int it = 0; it < 2; ++it) UNR for (int e = 0; e < 8; ++e) { const unsigned w = pk[it * 8 + e];
                        const float v0 = o[it][2 * e] + __uint_as_float(w << 16), v1 = o[it][2 * e + 1] + __uint_as_float(w & 0xffff0000u);
                        const int ra = 2 * e, rc = 2 * e + 1;
                        *(LAS float*)(lds + G2_OB + ((32 * it + (ra & 3) + 8 * (ra >> 2) + 4 * hi) * 256 + dv) * 4) = v0;
                        *(LAS float*)(lds + G2_OB + ((32 * it + (rc & 3) + 8 * (rc >> 2) + 4 * hi) * 256 + dv) * 4) = v1; } }
                LDS_BARRIER();
                { const int tok = t_ >> 3, part = t_ & 7; const LAS f32x4* op = (const LAS f32x4*)(lds + G2_OB + (tok * 256 + 32 * part) * 4);
                  float ss = 0.f;
                  UNR for (int k = 0; k < 8; ++k) { const f32x4 t = op[k]; ss += (t[0] * t[0] + t[1] * t[1]) + (t[2] * t[2] + t[3] * t[3]); }
                  ss += swz_xor<1>(ss); ss += swz_xor<2>(ss); ss += swz_xor<4>(ss);
                  const float rs = rsqrtf(ss * (1.f / 256.f) + EPS);
                  const bf16* rp = B.QKVR + (size_t)r0 * 3072 + 2048 + h * 256 + (tok * 3072 + 32 * part); bf16* ap = A3 + (size_t)r0 * GDV + h * 256 + (tok * GDV + 32 * part); const float* np_ = onorm + 32 * part;
                  UNR for (int k = 0; k < 4; ++k) { const u32x4 rw = prr[k]; const f32x4 n0 = *(const f32x4*)(np_ + 8 * k), n1 = *(const f32x4*)(np_ + 8 * k + 4); const f32x4 a0 = op[2 * k], a1 = op[2 * k + 1];
                      const unsigned rr[4] = {rw.x, rw.y, rw.z, rw.w}; float y[8];
                      UNR for (int e = 0; e < 4; ++e) { const float rl = __uint_as_float(rr[e] << 16), rh = __uint_as_float(rr[e] & 0xffff0000u);
                          const float oa = e < 2 ? a0[2 * e] : a1[2 * e - 4], ob = e < 2 ? a0[2 * e + 1] : a1[2 * e - 3]; const float na = e < 2 ? n0[2 * e] : n1[2 * e - 4], nb = e < 2 ? n0[2 * e + 1] : n1[2 * e - 3];
                          y[2 * e] = oa * rs * na * siluf(rl); y[2 * e + 1] = ob * rs * nb * siluf(rh); }
                      u32x4 w; w.x = cvtpk(y[0], y[1]); w.y = cvtpk(y[2], y[3]); w.z = cvtpk(y[4], y[5]); w.w = cvtpk(y[6], y[7]); *(u32x4*)(ap + 8 * k) = w; } }
            }
        }
    }
}
#define GAS __attribute__((address_space(1)))
#define XB_TMO      128
#define XB_XCNT(j)  (256  + 64 * (j))
#define XB_XSUB(j)  (1280 + 64 * (j))
#define XB_XGEN(j)  (2304 + 64 * (j))
#define XB_TOP      3328
#define XB_TOPGEN   3392
#define XCD_BAR_WORDS 3456
#define XB_SPIN_CAP (1u << 18)

__device__ __forceinline__ unsigned xb_ld(unsigned* p)              { return __hip_atomic_load(p, __ATOMIC_RELAXED, __HIP_MEMORY_SCOPE_AGENT); }
__device__ __forceinline__ unsigned xb_add(unsigned* p, unsigned v) { return __hip_atomic_fetch_add(p, v, __ATOMIC_RELAXED, __HIP_MEMORY_SCOPE_AGENT); }
__device__ __forceinline__ unsigned xb_xcc_id() { return (unsigned)__builtin_amdgcn_s_getreg((3 << 11) | 20) & 0xFu; }
#define XB_SPIN(cond, bar) do { unsigned _sp = 0; while (cond) { __builtin_amdgcn_s_sleep(1); \
    if ((++_sp & 255u) == 0u) { if (xb_ld(&(bar)[XB_TMO])) break; if (_sp > XB_SPIN_CAP) { atomicAdd(&(bar)[XB_TMO], 1u); break; } } } } while (0)

struct XcdBarrier {
    unsigned* bar; unsigned x;
    volatile LAS unsigned* st;
};

__device__ __forceinline__ XcdBarrier xcd_barrier_post(unsigned* bar, volatile LAS unsigned* st, int wave_s) {
    XcdBarrier b; b.bar = bar; b.x = xb_xcc_id(); b.st = st;
    if (hw_tid(wave_s) == 0) (void)xb_add(&bar[XB_XCNT(b.x)], 1u);
    return b;
}
__device__ __forceinline__ void xcd_barrier_complete(unsigned* bar, unsigned x, unsigned& nloc, unsigned& nx) {
    const unsigned G = gridDim.x * gridDim.y * gridDim.z;
    unsigned sum, cnt, mine, sp = 0u;
    for (;;) {
        sum = 0u; cnt = 0u; mine = 0u;
#pragma unroll
        for (unsigned j = 0; j < 16; ++j) { const unsigned c = xb_ld(&bar[XB_XCNT(j)]); sum += c; cnt += (c > 0u) ? 1u : 0u; mine = (j == x) ? c : mine; }
        if (sum == G) break;
        __builtin_amdgcn_s_sleep(1);
        if ((++sp & 255u) == 0u) { if (xb_ld(&bar[XB_TMO])) break; if (sp > XB_SPIN_CAP) { atomicAdd(&bar[XB_TMO], 1u); break; } }
    }
    nloc = mine > 0u ? mine : 1u; nx = cnt > 0u ? cnt : 1u;
}

__device__ __forceinline__ void xcd_barrier(const XcdBarrier& b, int wave_s) {
    asm volatile("s_waitcnt vmcnt(0)" ::: "memory");
    __syncthreads();
    if (hw_tid(wave_s) == 0) {
        unsigned* bar = b.bar;
        __builtin_amdgcn_s_waitcnt(0);
        unsigned nloc = b.st[0], nx = b.st[1];
        if (nloc == 0u) { xcd_barrier_complete(bar, b.x, nloc, nx); b.st[0] = nloc; b.st[1] = nx; }
        const unsigned old = xb_add(&bar[XB_XSUB(b.x)], 1u);
        const unsigned gen = old / nloc;
        if (old + 1u == (gen + 1u) * nloc) {
            __builtin_amdgcn_fence(__ATOMIC_RELEASE, "agent");
            asm volatile("s_waitcnt vmcnt(0)" ::: "memory");
            const unsigned og = xb_add(&bar[XB_TOP], 1u);
            const unsigned tg = og / nx;
            if (og + 1u == (tg + 1u) * nx) xb_add(&bar[XB_TOPGEN], 1u);
            else XB_SPIN(xb_ld(&bar[XB_TOPGEN]) == tg, bar);
            __builtin_amdgcn_fence(__ATOMIC_ACQUIRE, "agent");
            xb_add(&bar[XB_XGEN(b.x)], 1u);
            asm volatile("s_waitcnt vmcnt(0)" ::: "memory");
        } else {
            XB_SPIN(xb_ld(&bar[XB_XGEN(b.x)]) == gen, bar);
            __builtin_amdgcn_fence(__ATOMIC_ACQUIRE, "agent");
            asm volatile("s_waitcnt vmcnt(0)" ::: "memory");
        }
    }
    __syncthreads();
}


constexpr int NWAVES = 8, NTHREADS = 512;
constexpr int LDS_BYTES = 147456;
constexpr int PH_PRO = 0, PH_L0 = 1, PH_PER_LAYER = 9, PH_FIN = PH_L0 + DEPTH * PH_PER_LAYER, PH_COUNT = PH_FIN + 1;
struct Params { const float* in[20]; float* out; unsigned char* ws; int ph_lo, ph_hi; };

__device__ __forceinline__ float wave_sum(float v) {
    v += swz_xor<1>(v); v += swz_xor<2>(v); v += swz_xor<4>(v); v += swz_xor<8>(v); v += swz_xor<16>(v);
    { auto rr = __builtin_amdgcn_permlane32_swap(__float_as_uint(v), __float_as_uint(v), false, false); v = __uint_as_float(rr[0]) + __uint_as_float(rr[1]); }
    return v;
}
__device__ __forceinline__ int run_src(int kind, int n0, int s) {
    if (kind == 1) return n0 < GIN ? n0 + 16 * s : -1;
    if (kind == 2) { if (n0 >= SQ + SKVD) return n0 + 16 * s; const int hs = n0 >> 6, half = (n0 >> 5) & 1; return hs * 64 + 16 * half + 32 * s; }
    if (kind == 3) { const int q = n0 >> 5; return s ? FH + 16 * q : 16 * q; }
    return n0 + 16 * s;
}
__device__ __forceinline__ int run_pos(int kind, int n0, int s, int i) {
    if (kind == 2 && n0 < SQ + SKVD) return 2 * i + s;
    if (kind == 3) return 8 * (i >> 2) + 4 * s + (i & 3);
    return 16 * s + i;
}
__device__ __forceinline__ void transpose_item(const float* W, int K, int Nsrc, int Nnew, int kind, bf16* WT, LAS float* scr, int item, int lane) {
    const int nblk = Nnew / 32, kb = item / nblk, nb = item % nblk, k0 = 64 * kb, n0 = 32 * nb;
    const int s = (lane >> 2) & 1, f = lane & 3, kr = lane >> 3; const int sc = run_src(kind, n0, s);
    f32x4 v[8];
    UNR for (int it = 0; it < 8; ++it) v[it] = sc >= 0 ? *(const f32x4*)(W + (size_t)(k0 + kr + 8 * it) * Nsrc + sc + 4 * f) : (f32x4){0.f, 0.f, 0.f, 0.f};
    UNR for (int it = 0; it < 8; ++it) UNR for (int e = 0; e < 4; ++e) scr[(kr + 8 * it) * 33 + run_pos(kind, n0, s, 4 * f + e)] = v[it][e];
    asm volatile("s_waitcnt lgkmcnt(0)" ::: "memory");
    const int c = lane & 7;
    UNR for (int j = 0; j < 4; ++j) { const int n = (lane >> 3) + 8 * j; const LAS float* sp = scr + (8 * c) * 33 + n;
        u32x4 o; o.x = pk2(sp[0 * 33], sp[1 * 33]); o.y = pk2(sp[2 * 33], sp[3 * 33]); o.z = pk2(sp[4 * 33], sp[5 * 33]); o.w = pk2(sp[6 * 33], sp[7 * 33]);
        *(u32x4*)(WT + (size_t)(n0 + n) * K + k0 + 8 * c) = o; }
    asm volatile("s_waitcnt lgkmcnt(0)" ::: "memory");
}
__device__ __forceinline__ void prologue_phase(const Params& p, LAS unsigned char* lds, int tid, int lane, int wave, int G) {
    unsigned char* ws = p.ws;
    {
        LAS float* scr = (LAS float*)(lds + wave * 16384);
        const int gw = blockIdx.x * NWAVES + wave, NGW = G * NWAVES;
        constexpr int I_GIN = (D / 64) * (GINP / 32), I_GO = (GDV / 64) * (D / 32), I_SQKV = (D / 64) * (SQKV / 32), I_SO = (SQ / 64) * (D / 32), I_FIN = (D / 64) * (2 * FH / 32), I_FOUT = (FH / 64) * (D / 32);
        constexpr int NITEMS = 2 * (I_GIN + I_GO + I_SQKV + I_SO) + 4 * (I_FIN + I_FOUT);
        for (int it = gw; it < NITEMS; it += NGW) {
            int r = it;
            if (r < 2 * I_GIN) { const int j = r / I_GIN; transpose_item(p.in[8] + (size_t)j * D * GIN, D, GIN, GINP, 1, (bf16*)(ws + WS_WGIN + j * SZ_WGIN), scr, r % I_GIN, lane); continue; } r -= 2 * I_GIN;
            if (r < 2 * I_GO) { const int j = r / I_GO; transpose_item(p.in[11] + (size_t)j * GDV * D, GDV, D, D, 0, (bf16*)(ws + WS_WGO + j * SZ_WGO), scr, r % I_GO, lane); continue; } r -= 2 * I_GO;
            if (r < 2 * I_SQKV) { const int j = r / I_SQKV; transpose_item(p.in[13] + (size_t)j * D * SQKV, D, SQKV, SQKV, 2, (bf16*)(ws + WS_WSQKV + j * SZ_WSQKV), scr, r % I_SQKV, lane); continue; } r -= 2 * I_SQKV;
            if (r < 2 * I_SO) { const int j = r / I_SO; transpose_item(p.in[15] + (size_t)j * SQ * D, SQ, D, D, 0, (bf16*)(ws + WS_WSO + j * SZ_WSO), scr, r % I_SO, lane); continue; } r -= 2 * I_SO;
            if (r < 4 * I_FIN) { const int j = r / I_FIN; transpose_item(p.in[17] + (size_t)j * D * 2 * FH, D, 2 * FH, 2 * FH, 3, (bf16*)(ws + WS_WFIN + j * SZ_WFIN), scr, r % I_FIN, lane); continue; } r -= 4 * I_FIN;
            { const int j = r / I_FOUT; transpose_item(p.in[18] + (size_t)j * FH * D, FH, D, D, 0, (bf16*)(ws + WS_WFOUT + j * SZ_WFOUT), scr, r % I_FOUT, lane); }
        }
    }
    { float* rope = (float*)(ws + WS_ROPE);
      for (int idx = blockIdx.x * NTHREADS + tid; idx < SEQ * 32; idx += G * NTHREADS) { const int pp = idx & 31, t = idx >> 5;
          const float pos = (pp < 16) ? (float)(t / GRID_W) : (float)(t % GRID_W); const float inv = powf(10000.f, -(float)(pp & 15) / 16.f);
          float sn, cs; sincosf(pos * inv, &sn, &cs); rope[2 * idx] = cs; rope[2 * idx + 1] = sn; } }
    {
        __syncthreads();
        LAS float* sv = (LAS float*)lds;
        LAS float* red = (LAS float*)(lds + 3 * 1024 * 4);
        for (int i = tid; i < D; i += NTHREADS) { sv[i] = siluf(p.in[1][i]); sv[D + i] = siluf(p.in[1][D + i]); sv[2 * D + i] = siluf(p.in[3][i]); }
        __syncthreads();
        float* mod = (float*)(ws + WS_MOD);
        const int cg4 = tid & 7, kg = tid >> 3;
        for (int it = blockIdx.x; it < DEPTH * (6 * D / 32); it += G) {
            const int l = it / (6 * D / 32), e0 = (it % (6 * D / 32)) * 32;
            const float* w = p.in[4] + (size_t)l * D * 6 * D + (size_t)(kg * 16) * 6 * D + e0 + 4 * cg4;
            f32x4 wv[16];
            UNR for (int k = 0; k < 16; ++k) wv[k] = *(const f32x4*)(w + (size_t)k * 6 * D);
            f32x4 a0 = {0.f, 0.f, 0.f, 0.f}, a1 = a0, a2 = a0;
            UNR for (int k = 0; k < 16; ++k) { const int kk = kg * 16 + k; a0 += wv[k] * sv[kk]; a1 += wv[k] * sv[D + kk]; a2 += wv[k] * sv[2 * D + kk]; }
            UNR for (int e = 0; e < 4; ++e) { red[(kg * 32 + 4 * cg4 + e) * 3 + 0] = a0[e]; red[(kg * 32 + 4 * cg4 + e) * 3 + 1] = a1[e]; red[(kg * 32 + 4 * cg4 + e) * 3 + 2] = a2[e]; }
            __syncthreads();
            if (tid < 96) { const int v = tid >> 5, cl = tid & 31; float s = p.in[5][l * 6 * D + e0 + cl];
#pragma unroll 8
                for (int g = 0; g < 64; ++g) s += red[(g * 32 + cl) * 3 + v];
                mod[((size_t)l * 3 + v) * 6 * D + e0 + cl] = s; }
            __syncthreads();
        }
    }
}
__device__ __forceinline__ void norm_ctx_rows(const float* src_ctx_f32  , bf16* Xb, const float* w, const float* modl, int sh_off, bf16* XNp,
                                              const float* slab, int nslab, LAS unsigned char* lds, int tid) {
    const int lane = tid & 63, wave = __builtin_amdgcn_readfirstlane(tid >> 6);
    if ((int)blockIdx.x * 2 >= MC) { __syncthreads(); return; }
    const int rc = 2 * (int)blockIdx.x + (wave >> 2), r = MX + rc, col = 256 * (wave & 3) + 4 * lane;
    f32x4 v;
    if (src_ctx_f32) v = *(const f32x4*)(src_ctx_f32 + (size_t)rc * D + col);
    else { const u32x2 w2 = *(const u32x2*)(Xb + (size_t)r * D + col); v = (f32x4){__uint_as_float(w2.x << 16), __uint_as_float(w2.x & 0xffff0000u), __uint_as_float(w2.y << 16), __uint_as_float(w2.y & 0xffff0000u)}; }
    f32x4 sl[11];
    UNR for (int ks = 0; ks < 11; ++ks) sl[ks] = ks < nslab ? *(const f32x4*)(slab + ((size_t)ks * MC + rc) * D + col) : (f32x4){0.f, 0.f, 0.f, 0.f};
    UNR for (int ks = 0; ks < 11; ++ks) v += sl[ks];
    { u32x2 o; o.x = pk2(v[0], v[1]); o.y = pk2(v[2], v[3]); *(u32x2*)(Xb + (size_t)r * D + col) = o; }
    const float s = wave_sum((v[0] * v[0] + v[1] * v[1]) + (v[2] * v[2] + v[3] * v[3]));
    LAS float* red = (LAS float*)lds;
    if (lane == 0) red[wave] = s;
    __syncthreads();
    const int w0 = wave & 4; const float rs = rsqrtf(((red[w0] + red[w0 + 1]) + (red[w0 + 2] + red[w0 + 3])) * (1.f / D) + EPS);
    const float* mm = modl + (size_t)2 * 6 * D + sh_off;
    const f32x4 y = v * rs * (*(const f32x4*)(w + col) * (*(const f32x4*)(mm + D + col) + 1.f)) + *(const f32x4*)(mm + col);
    u32x2 o; o.x = pk2(y[0], y[1]); o.y = pk2(y[2], y[3]); *(u32x2*)(XNp + (size_t)r * D + col) = o;
}
__device__ __forceinline__ void norm_phase(const float* src_lat, const float* src_ctx, const float* w, const float* modl, int sh_off, bf16* XNp, int M, int gw, int NGW, int lane, bf16* Xcopy  , const float* slab, int nslab) {
    int curvec = -1; f32x4 gg[4], sh[4];
    for (int r = gw; r < M; r += NGW) {
        const int vec = rowvec(r);
        if (vec != curvec) { curvec = vec; const float* m = modl + (size_t)vec * 6 * D + sh_off;
            UNR for (int j = 0; j < 4; ++j) { const int c = lane * 4 + 256 * j; const f32x4 wv = *(const f32x4*)(w + c), sc = *(const f32x4*)(m + D + c); gg[j] = wv * (sc + 1.f); sh[j] = *(const f32x4*)(m + c); } }
        f32x4 v[4]; float s = 0.f;
        if (src_lat) { const f32x4* x = (const f32x4*)(r < MX ? src_lat + (size_t)r * D : src_ctx + (size_t)(r - MX) * D) + lane; UNR for (int j = 0; j < 4; ++j) v[j] = x[64 * j]; }
        else { const u32x2* x = (const u32x2*)(Xcopy + (size_t)r * D) + lane; UNR for (int j = 0; j < 4; ++j) { const u32x2 w = x[64 * j]; v[j] = (f32x4){__uint_as_float(w.x << 16), __uint_as_float(w.x & 0xffff0000u), __uint_as_float(w.y << 16), __uint_as_float(w.y & 0xffff0000u)}; } }
        UNR for (int j = 0; j < 4; ++j) s += (v[j][0] * v[j][0] + v[j][1] * v[j][1]) + (v[j][2] * v[j][2] + v[j][3] * v[j][3]);
        if (Xcopy && r >= MX) {
            for (int ks = 0; ks < nslab; ++ks) { const f32x4* sp = (const f32x4*)(slab + ((size_t)ks * MC + (r - MX)) * D) + lane; UNR for (int j = 0; j < 4; ++j) v[j] += sp[64 * j]; }
            s = 0.f;
            UNR for (int j = 0; j < 4; ++j) { u32x2 o; o.x = pk2(v[j][0], v[j][1]); o.y = pk2(v[j][2], v[j][3]); *((u32x2*)(Xcopy + (size_t)r * D) + lane + 64 * j) = o; s += (v[j][0] * v[j][0] + v[j][1] * v[j][1]) + (v[j][2] * v[j][2] + v[j][3] * v[j][3]); } }
        const float rs = rsqrtf(wave_sum(s) * (1.f / D) + EPS);
        UNR for (int j = 0; j < 4; ++j) { const f32x4 y = v[j] * rs * gg[j] + sh[j]; u32x2 o; o.x = pk2(y[0], y[1]); o.y = pk2(y[2], y[3]); *(u32x2*)(XNp + (size_t)r * D + lane * 4 + 256 * j) = o; }
    }
}
__device__ __forceinline__ void final_norm_phase(const bf16* X, const float* w, float* out, int gw, int NGW, int lane) {
    f32x4 wv[4];
    UNR for (int j = 0; j < 4; ++j) wv[j] = *(const f32x4*)(w + lane * 4 + 256 * j);
    for (int r = gw; r < MX; r += NGW) {
        const u32x2* x = (const u32x2*)(X + (size_t)r * D) + lane; f32x4 v[4]; float s = 0.f;
        UNR for (int j = 0; j < 4; ++j) { const u32x2 w2 = x[64 * j]; v[j] = (f32x4){__uint_as_float(w2.x << 16), __uint_as_float(w2.x & 0xffff0000u), __uint_as_float(w2.y << 16), __uint_as_float(w2.y & 0xffff0000u)}; s += (v[j][0] * v[j][0] + v[j][1] * v[j][1]) + (v[j][2] * v[j][2] + v[j][3] * v[j][3]); }
        const float rs = rsqrtf(wave_sum(s) * (1.f / D) + EPS);
        UNR for (int j = 0; j < 4; ++j) *((f32x4*)(out + (size_t)r * D) + lane + 64 * j) = v[j] * rs * wv[j];
    }
}

__global__ void __launch_bounds__(NTHREADS, 2) mega(Params p) {
    extern __shared__ __attribute__((aligned(16))) unsigned char lds_raw[];
    LAS unsigned char* lds = (LAS unsigned char*)lds_raw;
    const int G = gridDim.x;
    unsigned char* ws = p.ws;
    bf16* X = (bf16*)(ws + WS_X); bf16* XNp = (bf16*)(ws + WS_XN); const float* mod = (const float*)(ws + WS_MOD);
    volatile LAS unsigned* MISC = (volatile LAS unsigned*)(lds + LDS_BYTES - 64);
    const int wave_s = __builtin_amdgcn_readfirstlane((int)threadIdx.x >> 6);
    if (hw_tid(wave_s) < 16) MISC[hw_tid(wave_s)] = 0u;
    __syncthreads();
    XcdBarrier bar = xcd_barrier_post((unsigned*)(ws + WS_CTL), MISC + 8, wave_s);
    for (int ph = p.ph_lo; ph < p.ph_hi; ++ph) {
        int tid = hw_tid(wave_s); asm volatile("" : "+v"(tid));
        const int lane = tid & 63, wave = __builtin_amdgcn_readfirstlane(tid >> 6);
        const int gw = blockIdx.x * NWAVES + wave, NGW = G * NWAVES;
        if (ph == PH_PRO) { prologue_phase(p, lds, tid, lane, wave, G); }
        else if (ph == PH_FIN) { final_norm_phase(X, p.in[19], p.out, gw, NGW, lane); }
        else {
            const int l = (ph - PH_L0) / PH_PER_LAYER, s = (ph - PH_L0) % PH_PER_LAYER, j = l >> 1; const bool gla = (l & 1) == 0, last = (l == DEPTH - 1);
            const float* modl = mod + (size_t)l * 3 * 6 * D;
            const float* src_lat = l == 0 ? p.in[0] : nullptr; const float* src_ctx = l == 0 ? p.in[2] : nullptr;
            const int Mrows = last ? MX : MT;
            if (s == 0) { norm_ctx_rows(src_ctx, X, p.in[6] + l * D, modl, 0, XNp, p.out, l == 0 ? 0 : 11, lds, tid);
                          norm_phase(src_lat, src_ctx, p.in[6] + l * D, modl, 0, XNp, MX, gw, NGW, lane, X, p.out, 0); }
            else if (s == 1) {
                if (gla) { pg8::Gemm g{XNp, (const bf16*)(ws + WS_WGIN + j * SZ_WGIN), MT, GINP, D, D}; pg8::StaticOrder S; S.init(MT, GINP, G, (int)blockIdx.x);
                    EpiGlaIn E{(bf16*)(ws + WS_QKVR), (float*)(ws + WS_GF)};
                    pg8::gemm_phase<EpiGlaIn, pg8::StaticOrder, true, true>(lds, g, S, E, wave_s); }
                else { pg8::Gemm g{XNp, (const bf16*)(ws + WS_WSQKV + j * SZ_WSQKV), MT, SQKV, D, D}; pg8::StaticOrder S; S.init(MT, SQKV, G, (int)blockIdx.x);
                    EpiSwaQkv E{(bf16*)(ws + WS_SQ), (bf16*)(ws + WS_SK), (bf16*)(ws + WS_SV), p.in[14] + j * SQKV, (const float*)(ws + WS_ROPE)};
                    pg8::gemm_phase<EpiSwaQkv, pg8::StaticOrder, true, true>(lds, g, S, E, wave_s); }
            }
            else if (s >= 2 && s <= 4) {
                if (gla) {
                    bf16* scr = (bf16*)p.out;
                    const GlaBufs GB{(const bf16*)(ws + WS_QKVR), (const float*)(ws + WS_GF), scr, scr + (size_t)MT * 512, scr + (size_t)2 * MT * 512, (bf16*)(ws + WS_KIB), (float*)(ws + WS_DEC), (bf16*)(ws + WS_LS), (float*)(ws + WS_DSEG), (unsigned*)(ws + WS_STASH)};
                    if (s == 2) gla_g1_phase(GB, p.in[9] + (size_t)j * 2 * 16 * 512, p.in[10] + (size_t)j * 2 * 512, lds, tid);
                    else if (s == 3) gla_g1c_phase(GB.LS, GB.DSEG, tid);
                    else gla_g2_phase(GB, p.in[12] + j * GHV, XNp, lds, tid);
                } else if (s == 2) swa_phase((const bf16*)(ws + WS_SQ), (const bf16*)(ws + WS_SK), (const bf16*)(ws + WS_SV), p.in[16] + j * SH, XNp, !last, lds, tid);
                else continue;
            }
            else if (s == 5) {
                const bf16* Wt = (const bf16*)(gla ? ws + WS_WGO + j * SZ_WGO : ws + WS_WSO + j * SZ_WSO);
                { pg8::Gemm g{XNp, Wt, MX, D, D, D}; pg8::StaticOrder S; S.init(MX, D, G, (int)blockIdx.x);
                  EpiResid E{src_lat, X, modl + 2 * D};
                  pg8::gemm_phase<EpiResid, pg8::StaticOrder, true, true>(lds, g, S, E, wave_s); }
                if (!last) { int ksl = 256; asm volatile("" : "+s"(ksl));
                  pg8::Gemm g{XNp, Wt, MT, D, ksl, D}; pg8::SplitOrder S{4, 512, (int)blockIdx.x};
                  EpiSlab E{p.out, modl + 2 * D, 512};
                  pg8::gemm_phase<EpiSlab, pg8::SplitOrder, true, true>(lds, g, S, E, wave_s); }
            }
            else if (s == 6) { if (!last) norm_ctx_rows(nullptr, X, p.in[7] + l * D, modl, 3 * D, XNp, p.out, 4, lds, tid);
                               norm_phase(nullptr, nullptr, p.in[7] + l * D, modl, 3 * D, XNp, MX, gw, NGW, lane, X, p.out, 0); }
            else if (s == 7) {
                pg8::Gemm g{XNp, (const bf16*)(ws + WS_WFIN + l * SZ_WFIN), Mrows, 2 * FH, D, D}; pg8::StaticOrder S; S.init(Mrows, 2 * FH, G, (int)blockIdx.x);
                EpiSwiglu E{(bf16*)(ws + WS_HFF)};
                pg8::gemm_phase<EpiSwiglu, pg8::StaticOrder, true, true>(lds, g, S, E, wave_s);
            }
            else if (s == 8) {
                const bf16* Wt = (const bf16*)(ws + WS_WFOUT + l * SZ_WFOUT);
                { pg8::Gemm g{(const bf16*)(ws + WS_HFF), Wt, MX, D, FH, FH}; pg8::StaticOrder S; S.init(MX, D, G, (int)blockIdx.x);
                  EpiResid E{nullptr, X, modl + 5 * D};
                  pg8::gemm_phase<EpiResid, pg8::StaticOrder, true, true>(lds, g, S, E, wave_s); }
                if (!last) { int ksl = 256; asm volatile("" : "+s"(ksl));
                  pg8::Gemm g{(const bf16*)(ws + WS_HFF), Wt, MT, D, ksl, FH}; pg8::SplitOrder S{11, 512, (int)blockIdx.x};
                  EpiSlab E{p.out, modl + 5 * D, 512};
                  pg8::gemm_phase<EpiSlab, pg8::SplitOrder, true, true>(lds, g, S, E, wave_s); }
            }
        }
        if (ph + 1 < p.ph_hi) xcd_barrier(bar, wave_s);
    }
}

extern "C" void kernel_launch(void* const* d_in, const int* in_sizes, int n_in, void* d_out, int out_size, void* d_ws, size_t ws_size, hipStream_t stream) {
    static int grid = 0;
    if (grid == 0) {
        if (n_in != 20 || ws_size < WS_END || out_size != MX * D) { fprintf(stderr, "kernel_launch: unexpected problem (n_in %d, ws %zu, out %d)\n", n_in, ws_size, out_size); grid = -1; return; }
        int dev = 0, cus = 0, per_cu = 0;
        if (hipGetDevice(&dev) != hipSuccess || hipDeviceGetAttribute(&cus, hipDeviceAttributeMultiprocessorCount, dev) != hipSuccess) { grid = -1; return; }
        if (hipFuncSetAttribute((const void*)mega, hipFuncAttributeMaxDynamicSharedMemorySize, LDS_BYTES) != hipSuccess) { fprintf(stderr, "kernel_launch: hipFuncSetAttribute failed\n"); grid = -1; return; }
        if (hipOccupancyMaxActiveBlocksPerMultiprocessor(&per_cu, (const void*)mega, NTHREADS, LDS_BYTES) != hipSuccess || per_cu < 1) { fprintf(stderr, "kernel_launch: occupancy query says %d\n", per_cu); grid = -1; return; }
        grid = cus;
    }
    if (grid < 0) return;
    if (hipMemsetAsync((char*)d_ws + WS_CTL, 0, CTL_ZERO_BYTES, stream) != hipSuccess) { fprintf(stderr, "kernel_launch: memset failed\n"); return; }
    Params p{};
    for (int i = 0; i < 20; ++i) p.in[i] = (const float*)d_in[i];
    p.out = (float*)d_out; p.ws = (unsigned char*)d_ws;
    p.ph_lo = 0; p.ph_hi = PH_COUNT;
    void* args[] = {&p};
    hipError_t e = hipLaunchCooperativeKernel((const void*)mega, dim3(grid), dim3(NTHREADS), args, LDS_BYTES, stream);
    if (e != hipSuccess) fprintf(stderr, "cooperative launch failed: %s (grid %d)\n", hipGetErrorString(e), grid);
}
```
